# Optimizing an MI355X kernel written in HIP

```python
import jax, jax.numpy as jnp
from jax import lax
import numpy as np

D_MODEL = 1024
BATCH = 8
SEQ = 2048
DEPTH = 2

CHUNK = 64
Q_BLOCK = 128
EPS = 1e-6
GLA_HEADS = 4
GLA_DK = 48
GLA_DV = 96
GLA_RANK = 16
GLA_TAU = 16.0
SB_HEADS = 6
SB_DH = 64
CONV_CH = 256
CONV_WIDTH = 31
D_FF = 2816
N_MOD = 9

GLA_QK = GLA_HEADS * GLA_DK
GLA_V = GLA_HEADS * GLA_DV
SB_W = SB_HEADS * SB_DH
MIX_W = GLA_V + SB_W + CONV_CH
IN_COLS = 2 * GLA_QK + 2 * GLA_V + GLA_RANK + 3 * SB_W + 2 * CONV_CH

kernel_name = "hybrid_gla_stickbreak_conformer_block"


def rms_norm(x, g):
    xf = x.astype(jnp.float32)
    y = xf * lax.rsqrt(jnp.mean(xf * xf, axis=-1, keepdims=True) + EPS)
    return (y * g.astype(jnp.float32)).astype(x.dtype)


def layer_norm(x, g, b):
    xf = x.astype(jnp.float32)
    mu = jnp.mean(xf, axis=-1, keepdims=True)
    xc = xf - mu
    y = xc * lax.rsqrt(jnp.mean(xc * xc, axis=-1, keepdims=True) + EPS)
    return (y * g.astype(jnp.float32) + b.astype(jnp.float32)).astype(x.dtype)


def modulate(x, g, shift, scale):
    return rms_norm(x, g) * (1.0 + scale[:, None, :]) + shift[:, None, :]


def swiglu(h, w_in, w_out):
    a, b = jnp.split(h @ w_in, 2, axis=-1)
    return (jax.nn.silu(a) * b) @ w_out


def split_heads(t, n_heads):
    B, T, _ = t.shape
    return t.reshape(B, T, n_heads, -1).transpose(0, 2, 1, 3)


def merge_heads(t):
    B, H, T, d = t.shape
    return t.transpose(0, 2, 1, 3).reshape(B, T, H * d)


def gla_chunked(q, k, v, log_a):
    B, H, T, DK = q.shape
    DV = v.shape[-1]
    NC = T // CHUNK

    def to_chunks(t):
        return jnp.moveaxis(t.reshape(B, H, NC, CHUNK, t.shape[-1]), 2, 0)

    qc, kc, vc, gc = to_chunks(q), to_chunks(k), to_chunks(v), to_chunks(log_a)
    causal = jnp.tril(jnp.ones((CHUNK, CHUNK), dtype=bool))

    def step(S, inp):
        qi, ki, vi, gi = inp
        b = jnp.cumsum(gi, axis=2)
        o_inter = jnp.einsum('bhtk,bhkv->bhtv', qi * jnp.exp(b), S)
        diff = b[:, :, :, None, :] - b[:, :, None, :, :]
        decay = jnp.exp(jnp.where(causal[:, :, None], diff, -jnp.inf))
        scores = jnp.einsum('bhtk,bhsk,bhtsk->bhts', qi, ki, decay)
        o_intra = jnp.einsum('bhts,bhsv->bhtv', scores, vi)
        b_last = b[:, :, -1:, :]
        k_dec = ki * jnp.exp(b_last - b)
        S_new = jnp.exp(b_last[:, :, 0, :])[..., None] * S + jnp.einsum('bhsk,bhsv->bhkv', k_dec, vi)
        return S_new, o_inter + o_intra

    S0 = jnp.zeros((B, H, DK, DV), jnp.float32)
    _, o = lax.scan(step, S0, (qc, kc, vc, gc))
    return jnp.moveaxis(o, 0, 2).reshape(B, H, T, DV)


def stick_breaking(q, k, v):
    T = q.shape[2]
    scale = SB_DH ** -0.5
    outs = []
    for i in range(T // Q_BLOCK):
        q0 = i * Q_BLOCK
        kv_len = q0 + Q_BLOCK
        qb = q[:, :, q0:kv_len]
        kb = k[:, :, :kv_len]
        vb = v[:, :, :kv_len]
        z = jnp.einsum('bhqd,bhkd->bhqk', qb, kb) * scale
        t_idx = q0 + jnp.arange(Q_BLOCK)[:, None]
        s_idx = jnp.arange(kv_len)[None, :]
        mask = s_idx < t_idx
        log_keep = jnp.where(mask, jax.nn.log_sigmoid(-z), 0.0)
        cum = jnp.cumsum(log_keep, axis=-1)
        log_w = jax.nn.log_sigmoid(z) + (cum[..., -1:] - cum)
        w = jnp.where(mask, jnp.exp(log_w), 0.0)
        outs.append(jnp.einsum('bhqk,bhkd->bhqd', w, vb))
    return jnp.concatenate(outs, axis=2)


def causal_depthwise_conv(u, w, b):
    out = lax.conv_general_dilated(
        u, w[:, None, :], window_strides=(1,), padding=[(CONV_WIDTH - 1, 0)],
        dimension_numbers=('NWC', 'WIO', 'NWC'), feature_group_count=u.shape[-1])
    return out + b


def hybrid_mixer(h, w_in, w_out, gla_w_gate_up, gla_b_gate, gla_out_norm,
                 sb_q_norm, sb_k_norm, sb_out_norm, conv_w, conv_b, conv_ln_g, conv_ln_b):
    dt = h.dtype
    proj = h @ w_in
    idx = [GLA_QK, 2 * GLA_QK, 2 * GLA_QK + GLA_V, 2 * GLA_QK + 2 * GLA_V,
           2 * GLA_QK + 2 * GLA_V + GLA_RANK]
    idx = idx + [idx[-1] + SB_W, idx[-1] + 2 * SB_W, idx[-1] + 3 * SB_W]
    g_q, g_k, g_v, g_g, g_r, s_q, s_k, s_v, c_u = jnp.split(proj, idx, axis=-1)

    log_a = jax.nn.log_sigmoid(g_r @ gla_w_gate_up + gla_b_gate) / GLA_TAU
    qa = split_heads(g_q, GLA_HEADS).astype(jnp.float32) * (GLA_DK ** -0.5)
    ka = split_heads(g_k, GLA_HEADS).astype(jnp.float32)
    va = split_heads(g_v, GLA_HEADS).astype(jnp.float32)
    la = split_heads(log_a, GLA_HEADS).astype(jnp.float32)
    oa = rms_norm(gla_chunked(qa, ka, va, la), gla_out_norm)
    out_a = merge_heads(oa).astype(dt) * jax.nn.silu(g_g)

    qb = rms_norm(split_heads(s_q, SB_HEADS), sb_q_norm).astype(jnp.float32)
    kb = rms_norm(split_heads(s_k, SB_HEADS), sb_k_norm).astype(jnp.float32)
    vb = split_heads(s_v, SB_HEADS).astype(jnp.float32)
    ob = rms_norm(stick_breaking(qb, kb, vb), sb_out_norm)
    out_b = merge_heads(ob).astype(dt)

    cu_a, cu_g = jnp.split(c_u, 2, axis=-1)
    u = cu_a * jax.nn.sigmoid(cu_g)
    u = causal_depthwise_conv(u, conv_w, conv_b)
    out_c = jax.nn.silu(layer_norm(u, conv_ln_g, conv_ln_b))

    return jnp.concatenate([out_a, out_b, out_c], axis=-1) @ w_out


def setup_inputs(seed: int = 0) -> dict:
    key = jax.random.key(seed)
    ks = jax.random.split(key, 24)
    L, D = DEPTH, D_MODEL

    def nrm(k, shape, s):
        return jax.random.normal(k, shape, jnp.float32) * s

    def gain(k, shape):
        return 1.0 + 0.02 * jax.random.normal(k, shape, jnp.float32)

    return {
        "x": nrm(ks[0], (BATCH, SEQ, D), 1.0),
        "c": nrm(ks[1], (BATCH, D), 1.0),
        "w_ada": nrm(ks[2], (L, D, N_MOD * D), D ** -0.5),
        "b_ada": nrm(ks[3], (L, N_MOD * D), 0.02),
        "norm_ffn1": gain(ks[4], (L, D)),
        "ffn1_w_in": nrm(ks[5], (L, D, 2 * D_FF), D ** -0.5),
        "ffn1_w_out": nrm(ks[6], (L, D_FF, D), D_FF ** -0.5),
        "norm_mix": gain(ks[7], (L, D)),
        "w_in": nrm(ks[8], (L, D, IN_COLS), D ** -0.5),
        "w_out": nrm(ks[9], (L, MIX_W, D), MIX_W ** -0.5),
        "gla_w_gate_up": nrm(ks[10], (L, GLA_RANK, GLA_QK), GLA_RANK ** -0.5),
        "gla_b_gate": nrm(ks[11], (L, GLA_QK), 0.1),
        "gla_out_norm": gain(ks[12], (L, GLA_DV)),
        "sb_q_norm": gain(ks[13], (L, SB_DH)),
        "sb_k_norm": gain(ks[14], (L, SB_DH)),
        "sb_out_norm": gain(ks[15], (L, SB_DH)),
        "conv_w": nrm(ks[16], (L, CONV_WIDTH, CONV_CH), CONV_WIDTH ** -0.5),
        "conv_b": nrm(ks[17], (L, CONV_CH), 0.02),
        "conv_ln_g": gain(ks[18], (L, CONV_CH)),
        "conv_ln_b": nrm(ks[19], (L, CONV_CH), 0.02),
        "norm_ffn2": gain(ks[20], (L, D)),
        "ffn2_w_in": nrm(ks[21], (L, D, 2 * D_FF), D ** -0.5),
        "ffn2_w_out": nrm(ks[22], (L, D_FF, D), D_FF ** -0.5),
    }


def reference(x, c, w_ada, b_ada, norm_ffn1, ffn1_w_in, ffn1_w_out, norm_mix, w_in, w_out,
              gla_w_gate_up, gla_b_gate, gla_out_norm, sb_q_norm, sb_k_norm, sb_out_norm,
              conv_w, conv_b, conv_ln_g, conv_ln_b, norm_ffn2, ffn2_w_in, ffn2_w_out):
    c_act = jax.nn.silu(c)
    for l in range(DEPTH):
        mod = c_act @ w_ada[l] + b_ada[l]
        sh1, sc1, gt1, sh2, sc2, gt2, sh3, sc3, gt3 = jnp.split(mod, N_MOD, axis=-1)
        h = modulate(x, norm_ffn1[l], sh1, sc1)
        x = x + 0.5 * gt1[:, None, :] * swiglu(h, ffn1_w_in[l], ffn1_w_out[l])
        h = modulate(x, norm_mix[l], sh2, sc2)
        y = hybrid_mixer(h, w_in[l], w_out[l], gla_w_gate_up[l], gla_b_gate[l], gla_out_norm[l],
                         sb_q_norm[l], sb_k_norm[l], sb_out_norm[l],
                         conv_w[l], conv_b[l], conv_ln_g[l], conv_ln_b[l])
        x = x + gt2[:, None, :] * y
        h = modulate(x, norm_ffn2[l], sh3, sc3)
        x = x + 0.5 * gt3[:, None, :] * swiglu(h, ffn2_w_in[l], ffn2_w_out[l])
    return x
```

```cpp
#include <hip/hip_runtime.h>
#include <cstdio>
#include <cstdint>
#include <cmath>
namespace pg8 {
#define PG8_LAS __attribute__((address_space(3)))
typedef unsigned short bf16_t;
typedef short bf16x8 __attribute__((ext_vector_type(8)));
typedef float f32x4 __attribute__((ext_vector_type(4)));
typedef unsigned u32x4 __attribute__((ext_vector_type(4)));
constexpr int BM = 256, BK = 64, HALF = 128, HTB = HALF * BK * 2  , STAGE_BYTES = 8 * HTB, NXCD = 8, WGM = 8;

__host__ __device__ __forceinline__ int lds_byte(int r, int c) { const int st = (r >> 4) * 2 + (c >> 5), rr = r & 15, cc = c & 31, ob = rr * 64 + cc * 2; return st * 1024 + (ob ^ (((ob >> 9) & 1) << 5)); }
__host__ __device__ __forceinline__ void stage_rc(int b, int& R, int& C) { const int st = b / 1024, sb = b % 1024, swz = sb ^ (((sb >> 9) & 1) << 5); R = (st >> 1) * 16 + swz / 64; C = (st & 1) * 32 + (swz % 64) / 2; }
__host__ __device__ __forceinline__ int perm32(int rho) { const int n = rho >> 4, i = rho & 15; return 8 * (i >> 2) + 4 * n + (i & 3); }

struct Unit { int pm, pn; };
struct Gemm { const bf16_t* A; const bf16_t* Bt; int M, N, K; };

struct StaticOrder {
    int nM, nN, nwg, G, c;
    __host__ __device__ void init(int M, int N, int G_, int c_) { nM = M / BM; nN = N / BM; nwg = nM * nN; G = G_; c = c_; }
    __host__ __device__ bool next(int i, Unit& u) const {
        const long L = (long)i * G + c; if (L >= nwg) return false;
        int wgid = (int)L; { const int q = nwg / NXCD, r = nwg % NXCD, xcd = wgid % NXCD, off = wgid / NXCD; wgid = (xcd < r ? xcd * (q + 1) : r * (q + 1) + (xcd - r) * q) + off; }
        const int nig = WGM * nN, gid = wgid / nig, fm = gid * WGM, gsz = (nM - fm) < WGM ? (nM - fm) : WGM;
        u.pm = fm + ((wgid % nig) % gsz); u.pn = (wgid % nig) / gsz; return true;
    }
    __device__ __forceinline__ void a_ready(const Unit&) const {}
    __device__ __forceinline__ void done(const Unit&) const {}
};

__device__ __forceinline__ unsigned cvt_pk_bf16(float lo, float hi) { unsigned r; asm volatile("v_cvt_pk_bf16_f32 %0, %1, %2" : "=v"(r) : "v"(lo), "v"(hi)); return r; }
typedef float f32x2 __attribute__((ext_vector_type(2)));
__device__ __forceinline__ f32x2 gelu_pk(f32x2 v) {
    const f32x2 av = __builtin_elementwise_abs(v), d = av * 0.2316418882f + 1.0f;
    f32x2 t; t.x = __builtin_amdgcn_rcpf(d.x); t.y = __builtin_amdgcn_rcpf(d.y);
    f32x2 q = t * 0.5307027145f + (-0.7265760135f); q = q * t + 0.7107068705f; q = q * t + (-0.142248368f); q = q * t + 0.127414796f; q = q * t;
    const f32x2 s = (v * v) * (-0.72134752044f);
    f32x2 e; e.x = __builtin_amdgcn_exp2f(s.x); e.y = __builtin_amdgcn_exp2f(s.y);
    const f32x2 m = v * (q * e), r = v - m;
    f32x2 o; o.x = v.x < 0.f ? m.x : r.x; o.y = v.y < 0.f ? m.y : r.y; return o;
}

template <int ACT  > struct EpiBf16 {
    static constexpr bool PERM = true, AFTER_DRAIN = false; static_assert(ACT == 0 || ACT == 1, "EpiBf16: ACT is 0 (none) or 1 (gelu_pk)");
    bf16_t* O; int ldc; const float* bias; int split_cols; size_t split_stride; float scale0;
    __device__ __forceinline__ void operator()(const f32x4 (&acc)[2][2][4][2], const Unit& u, int wr, int wc, int fr, int fq) const {
        const int row0 = u.pm * BM + wr * 64 + fr; int colt = u.pn * BM; bf16_t* base = O;
        float sc = 1.f; if (split_cols) { const int t = colt / split_cols; base += (size_t)t * split_stride; colt -= t * split_cols; if (t == 0) sc = scale0; }
        const int col0 = colt + wc * 32 + 8 * fq, bcol0 = u.pn * BM + wc * 32 + 8 * fq;
        f32x4 bv[2][2];
#pragma unroll
        for (int bj = 0; bj < 2; ++bj)
#pragma unroll
            for (int n = 0; n < 2; ++n) bv[bj][n] = bias ? *(const f32x4*)(bias + bcol0 + bj * HALF + 4 * n) : (f32x4){0.f, 0.f, 0.f, 0.f};
#pragma unroll
        for (int ai = 0; ai < 2; ++ai)
#pragma unroll
            for (int m = 0; m < 4; ++m) { bf16_t* rowp = base + (size_t)(row0 + ai * HALF + m * 16) * ldc + col0;
#pragma unroll
                for (int bj = 0; bj < 2; ++bj) { f32x4 v0 = acc[ai][bj][m][0] + bv[bj][0], v1 = acc[ai][bj][m][1] + bv[bj][1];
                    if (ACT == 1) { f32x2 a = gelu_pk((f32x2){v0[0], v0[1]}), b = gelu_pk((f32x2){v0[2], v0[3]}), c = gelu_pk((f32x2){v1[0], v1[1]}), d = gelu_pk((f32x2){v1[2], v1[3]});
                        v0 = (f32x4){a.x, a.y, b.x, b.y}; v1 = (f32x4){c.x, c.y, d.x, d.y}; }
                    v0 = v0 * sc; v1 = v1 * sc; u32x4 w; w.x = cvt_pk_bf16(v0[0], v0[1]); w.y = cvt_pk_bf16(v0[2], v0[3]); w.z = cvt_pk_bf16(v1[0], v1[1]); w.w = cvt_pk_bf16(v1[2], v1[3]);
                    *(u32x4*)(rowp + bj * HALF) = w; } }
    }
};
__device__ __forceinline__ float silu_f(float a) { return a * __builtin_amdgcn_rcpf(1.0f + __builtin_amdgcn_exp2f(-1.4426950408889634f * a)); }
struct EpiSwiGLU {
    static constexpr bool PERM = true, AFTER_DRAIN = false;
    bf16_t* O; int ldc;
    __device__ __forceinline__ void operator()(const f32x4 (&acc)[2][2][4][2], const Unit& u, int wr, int wc, int fr, int fq) const {
        const int row0 = u.pm * BM + wr * 64 + fr, col0 = u.pn * HALF + wc * 32 + 8 * fq;
#pragma unroll
        for (int ai = 0; ai < 2; ++ai)
#pragma unroll
            for (int m = 0; m < 4; ++m) { bf16_t* rowp = O + (size_t)(row0 + ai * HALF + m * 16) * ldc + col0;
                const f32x4 a0 = acc[ai][0][m][0], a1 = acc[ai][0][m][1], b0 = acc[ai][1][m][0], b1 = acc[ai][1][m][1];
                f32x4 v0, v1;
#pragma unroll
                for (int j = 0; j < 4; ++j) { v0[j] = silu_f(a0[j]) * b0[j]; v1[j] = silu_f(a1[j]) * b1[j]; }
                u32x4 w; w.x = cvt_pk_bf16(v0[0], v0[1]); w.y = cvt_pk_bf16(v0[2], v0[3]); w.z = cvt_pk_bf16(v1[0], v1[1]); w.w = cvt_pk_bf16(v1[2], v1[3]);
                *(u32x4*)rowp = w; }
    }
};
struct EpiResid {
    static constexpr bool PERM = false, AFTER_DRAIN = false;
    const float* xin; float* out; const float* gate; float fac;
    __device__ __forceinline__ void operator()(const f32x4 (&acc)[2][2][4][2], const Unit& u, int wr, int wc, int fr, int fq) const {
        const int row0 = u.pm * BM + wr * 64 + fr, col0 = u.pn * BM + wc * 32 + 4 * fq;
        const float* g = gate + (size_t)(u.pm >> 3) * 9216 + col0;
        f32x4 gv[2][2];
#pragma unroll
        for (int bj = 0; bj < 2; ++bj)
#pragma unroll
            for (int n = 0; n < 2; ++n) gv[bj][n] = *(const f32x4*)(g + bj * HALF + n * 16) * fac;
#pragma unroll
        for (int ai = 0; ai < 2; ++ai)
#pragma unroll
            for (int m = 0; m < 4; ++m) { const size_t off = (size_t)(row0 + ai * HALF + m * 16) * 1024 + col0;
#pragma unroll
                for (int bj = 0; bj < 2; ++bj)
#pragma unroll
                    for (int n = 0; n < 2; ++n) { const f32x4 xv = *(const f32x4*)(xin + off + bj * HALF + n * 16);
                        *(f32x4*)(out + off + bj * HALF + n * 16) = xv + gv[bj][n] * acc[ai][bj][m][n]; }
                asm volatile("" ::: "memory"); }
    }
};
template <class Epi, class Sched, bool ALIGN_EPI = false, bool SP2 = false>
__device__ __forceinline__ void gemm_phase(PG8_LAS unsigned char* lds, const Gemm g, const Sched& S, const Epi& E) {
    const int tid = threadIdx.x, wid = __builtin_amdgcn_readfirstlane(tid >> 6), lane = tid & 63, wr = wid >> 2, wc = wid & 3, fr = lane & 15, fq = lane >> 4;
    const int K = g.K, nt = K / BK;
    unsigned voffA[2], voffB[2];
#pragma unroll
    for (int i = 0; i < 2; ++i) { int R, C; stage_rc(tid * 16 + i * 8192, R, C); const int Rb = Epi::PERM ? ((R & ~31) + perm32(R & 31)) : R;
        voffA[i] = (unsigned)(R * K + C) * 2u; voffB[i] = (unsigned)(Rb * K + C) * 2u; }
    const size_t kstep = (size_t)(BK * 2);
    const size_t hstep = (size_t)HALF * K * 2;
    const size_t tstep = 2 * hstep;
    const unsigned ldsw = (unsigned)wid * 1024u;
    const int aoff = lds_byte(wr * 64 + fr, fq * 8), boff = lds_byte(wc * 32 + fr, fq * 8);
#define PG8_SA(b, h) (((b) * 2 + (h)) * HTB)
#define PG8_SB(b, h) ((4 + (b) * 2 + (h)) * HTB)
#define PG8_STAGE(bufoff, gbase, voff) do { _Pragma("unroll") for (int _i = 0; _i < 2; ++_i) \
        __builtin_amdgcn_global_load_lds((const unsigned*)((const char*)(gbase) + (voff)[_i]), (PG8_LAS unsigned*)(lds + (bufoff) + ldsw + _i * 8192), 16, 0, 0); } while (0)
#define PG8_LDA(dst, b, h) do { _Pragma("unroll") for (int m = 0; m < 4; ++m) _Pragma("unroll") for (int k = 0; k < 2; ++k) dst[m][k] = *(const PG8_LAS bf16x8*)(lds + PG8_SA(b, h) + aoff + m * 2048 + k * 1024); } while (0)
#define PG8_LDB(dst, b, h) do { _Pragma("unroll") for (int n = 0; n < 2; ++n) _Pragma("unroll") for (int k = 0; k < 2; ++k) dst[n][k] = *(const PG8_LAS bf16x8*)(lds + PG8_SB(b, h) + boff + n * 2048 + k * 1024); } while (0)
#define PG8_MMA(ai, bj, At, Bt) do { __builtin_amdgcn_s_setprio(1); _Pragma("unroll") for (int m = 0; m < 4; ++m) _Pragma("unroll") for (int n = 0; n < 2; ++n) _Pragma("unroll") for (int k = 0; k < 2; ++k) \
        acc[ai][bj][m][n] = __builtin_amdgcn_mfma_f32_16x16x32_bf16(Bt[n][k], At[m][k], acc[ai][bj][m][n], 0, 0, 0); __builtin_amdgcn_s_setprio(0); } while (0)
#define PG8_WAIT_V(n) asm volatile("s_waitcnt vmcnt(" #n ")" ::: "memory")
#define PG8_WAIT_L(n) asm volatile("s_waitcnt lgkmcnt(" #n ")" ::: "memory")
#define PG8_BAR __builtin_amdgcn_s_barrier()
#define PG8_SCHED __builtin_amdgcn_sched_barrier(0)
    Unit cur, nxt; int ui = 0;
    if (!S.next(0, cur)) return;
    f32x4 acc[2][2][4][2];
#pragma unroll
    for (int a = 0; a < 2; ++a)
#pragma unroll
        for (int b = 0; b < 2; ++b)
#pragma unroll
            for (int m = 0; m < 4; ++m)
#pragma unroll
                for (int n = 0; n < 2; ++n) acc[a][b][m][n] = (f32x4){0.f, 0.f, 0.f, 0.f};
    bf16x8 At[4][2], B0[2][2], B1[2][2];
    const char* cA = (const char*)g.A + (size_t)cur.pm * tstep; const char* cB = (const char*)g.Bt + (size_t)cur.pn * tstep;
    S.a_ready(cur);
    if constexpr (SP2) {
        PG8_STAGE(PG8_SB(0, 0), cB, voffB); PG8_STAGE(PG8_SB(0, 1), cB + hstep, voffB); PG8_STAGE(PG8_SA(0, 0), cA, voffA); PG8_STAGE(PG8_SA(0, 1), cA + hstep, voffA);
        if (wr == 1) PG8_BAR;
        PG8_WAIT_V(2); PG8_BAR;
        PG8_STAGE(PG8_SB(1, 0), cB + kstep, voffB); PG8_STAGE(PG8_SA(1, 0), cA + kstep, voffA); PG8_STAGE(PG8_SB(1, 1), cB + hstep + kstep, voffB);
        PG8_WAIT_V(6); PG8_BAR;
    } else {
        PG8_STAGE(PG8_SB(0, 0), cB, voffB); PG8_STAGE(PG8_SA(0, 0), cA, voffA); PG8_STAGE(PG8_SB(0, 1), cB + hstep, voffB); PG8_STAGE(PG8_SA(0, 1), cA + hstep, voffA);
        if (wr == 1) PG8_BAR;
        PG8_WAIT_V(4); PG8_BAR;
        PG8_STAGE(PG8_SB(1, 0), cB + kstep, voffB); PG8_STAGE(PG8_SA(1, 0), cA + kstep, voffA); PG8_STAGE(PG8_SB(1, 1), cB + hstep + kstep, voffB);
        PG8_WAIT_V(6); PG8_BAR;
    }
    for (;;) {
        const bool has_next = S.next(ui + 1, nxt);
        const char* nA = has_next ? (const char*)g.A + (size_t)nxt.pm * tstep : cA; const char* nB = has_next ? (const char*)g.Bt + (size_t)nxt.pn * tstep : cB;
        for (int t = 0; t < nt; t += 2) {
            const bool last = (t == nt - 2);
            const char* a1 = cA + (size_t)(t + 1) * kstep;
            const char* a2 = last ? nA : cA + (size_t)(t + 2) * kstep; const char* b2 = last ? nB : cB + (size_t)(t + 2) * kstep;
            const char* a3 = a2 + kstep; const char* b3 = b2 + kstep;
            if (last && has_next) S.a_ready(nxt);
            if constexpr (SP2) {
            PG8_LDB(B0, 0, 0); PG8_LDB(B1, 0, 1); PG8_SCHED; PG8_LDA(At, 0, 0); PG8_STAGE(PG8_SA(1, 1), a1 + hstep, voffA);
            PG8_WAIT_V(8); PG8_WAIT_L(0); PG8_BAR; PG8_MMA(0, 0, At, B0); PG8_MMA(0, 1, At, B1); PG8_BAR; PG8_SCHED;
            PG8_LDA(At, 0, 1); PG8_STAGE(PG8_SB(0, 0), b2, voffB); PG8_STAGE(PG8_SB(0, 1), b2 + hstep, voffB); PG8_STAGE(PG8_SA(0, 0), a2, voffA);
            PG8_WAIT_V(8); PG8_WAIT_L(0); PG8_BAR; PG8_MMA(1, 0, At, B0); PG8_MMA(1, 1, At, B1); PG8_BAR; PG8_SCHED;
            PG8_LDB(B0, 1, 0); PG8_LDB(B1, 1, 1); PG8_SCHED; PG8_LDA(At, 1, 0); PG8_STAGE(PG8_SA(0, 1), a2 + hstep, voffA);
            PG8_WAIT_V(8); PG8_WAIT_L(0); PG8_BAR; PG8_MMA(0, 0, At, B0); PG8_MMA(0, 1, At, B1); PG8_BAR; PG8_SCHED;
            PG8_LDA(At, 1, 1); PG8_STAGE(PG8_SB(1, 0), b3, voffB); PG8_STAGE(PG8_SB(1, 1), b3 + hstep, voffB); PG8_STAGE(PG8_SA(1, 0), a3, voffA);
            PG8_WAIT_V(8); PG8_WAIT_L(0); PG8_BAR; PG8_MMA(1, 0, At, B0); PG8_MMA(1, 1, At, B1); PG8_BAR; PG8_SCHED;
            } else {
            PG8_LDB(B0, 0, 0); PG8_SCHED; PG8_LDA(At, 0, 0); PG8_STAGE(PG8_SA(1, 1), a1 + hstep, voffA);
            PG8_WAIT_L(8); PG8_BAR; PG8_WAIT_L(0); PG8_MMA(0, 0, At, B0); PG8_BAR; PG8_SCHED;
            PG8_LDB(B1, 0, 1); PG8_STAGE(PG8_SB(0, 0), b2, voffB);
            PG8_BAR; PG8_WAIT_L(0); PG8_MMA(0, 1, At, B1); PG8_BAR;
            PG8_LDA(At, 0, 1); PG8_STAGE(PG8_SA(0, 0), a2, voffA);
            PG8_BAR; PG8_WAIT_L(0); PG8_MMA(1, 0, At, B0); PG8_BAR; PG8_SCHED;
            PG8_STAGE(PG8_SB(0, 1), b2 + hstep, voffB);
            PG8_WAIT_V(6); PG8_BAR; PG8_MMA(1, 1, At, B1); PG8_BAR;
            PG8_LDB(B0, 1, 0); PG8_SCHED; PG8_LDA(At, 1, 0); PG8_STAGE(PG8_SA(0, 1), a2 + hstep, voffA);
            PG8_WAIT_L(8); PG8_BAR; PG8_WAIT_L(0); PG8_MMA(0, 0, At, B0); PG8_BAR; PG8_SCHED;
            PG8_LDB(B1, 1, 1); PG8_STAGE(PG8_SB(1, 0), b3, voffB);
            PG8_BAR; PG8_WAIT_L(0); PG8_MMA(0, 1, At, B1); PG8_BAR;
            PG8_LDA(At, 1, 1); PG8_STAGE(PG8_SA(1, 0), a3, voffA);
            PG8_BAR; PG8_WAIT_L(0); PG8_MMA(1, 0, At, B0); PG8_BAR; PG8_SCHED;
            PG8_STAGE(PG8_SB(1, 1), b3 + hstep, voffB);
            PG8_WAIT_V(6); PG8_BAR; PG8_MMA(1, 1, At, B1); PG8_BAR;
            }
        }
        if constexpr (ALIGN_EPI) { if (wr == 0) PG8_BAR; }
        if constexpr (!Epi::AFTER_DRAIN) { E(acc, cur, wr, wc, fr, fq); S.done(cur); }
        if (!has_next) break;
#pragma unroll
        for (int a = 0; a < 2; ++a)
#pragma unroll
            for (int b = 0; b < 2; ++b)
#pragma unroll
                for (int m = 0; m < 4; ++m)
#pragma unroll
                    for (int n = 0; n < 2; ++n) acc[a][b][m][n] = (f32x4){0.f, 0.f, 0.f, 0.f};
        cur = nxt; cA = nA; cB = nB; ++ui;
        if constexpr (ALIGN_EPI) { if (wr == 1) PG8_BAR; }
    }
    PG8_WAIT_V(0);
    if constexpr (!ALIGN_EPI) { if (wr == 0) PG8_BAR; }
    PG8_BAR;
    if constexpr (Epi::AFTER_DRAIN) { E.fused(acc, cur, wr, wc, fr, fq, lds, wid, lane); S.done(cur); }
#undef PG8_SA
#undef PG8_SB
#undef PG8_STAGE
#undef PG8_LDA
#undef PG8_LDB
#undef PG8_MMA
#undef PG8_WAIT_V
#undef PG8_WAIT_L
#undef PG8_BAR
#undef PG8_SCHED
}
}
#define GAS __attribute__((address_space(1)))
#define LAS __attribute__((address_space(3)))
typedef unsigned short bf16;
typedef unsigned v4u __attribute__((ext_vector_type(4)));
typedef float f32x4 __attribute__((ext_vector_type(4)));
typedef short bf16x8 __attribute__((ext_vector_type(8)));
typedef GAS unsigned gu32;
typedef GAS unsigned long long gu64;
#define RLX_AGENT __ATOMIC_RELAXED, __HIP_MEMORY_SCOPE_AGENT
#define LDS_WAIT() asm volatile("s_waitcnt lgkmcnt(0)" ::: "memory")
#define VM_WAIT() asm volatile("s_waitcnt vmcnt(0)" ::: "memory")
__device__ __forceinline__ unsigned long long rt() { return __builtin_amdgcn_s_memrealtime(); }
__device__ __forceinline__ unsigned f2bf(float f) { unsigned u = __builtin_bit_cast(unsigned, f); return (u + 0x7fffu + ((u >> 16) & 1u)) >> 16; }
__device__ __forceinline__ unsigned pk2(float lo, float hi) { return f2bf(lo) | (f2bf(hi) << 16); }
#define XB_TMO      128
#define XB_XCNT(j)  (256  + 64 * (j))
#define XB_XSUB(j)  (1280 + 64 * (j))
#define XB_XGEN(j)  (2304 + 64 * (j))
#define XB_TOP      3328
#define XB_TOPGEN   3392
#define XCD_BAR_WORDS 3456
#define XB_SPIN_CAP (1u << 18)

__device__ __forceinline__ unsigned xb_ld(unsigned* p)              { return __hip_atomic_load(p, __ATOMIC_RELAXED, __HIP_MEMORY_SCOPE_AGENT); }
__device__ __forceinline__ unsigned xb_add(unsigned* p, unsigned v) { return __hip_atomic_fetch_add(p, v, __ATOMIC_RELAXED, __HIP_MEMORY_SCOPE_AGENT); }
__device__ __forceinline__ unsigned xb_xcc_id() { return (unsigned)__builtin_amdgcn_s_getreg((3 << 11) | 20) & 0xFu; }
#define XB_SPIN(cond, bar) do { unsigned _sp = 0; while (cond) { __builtin_amdgcn_s_sleep(1); \
    if ((++_sp & 255u) == 0u) { if (xb_ld(&(bar)[XB_TMO])) break; if (_sp > XB_SPIN_CAP) { atomicAdd(&(bar)[XB_TMO], 1u); break; } } } } while (0)

struct XcdBarrier {
    unsigned* bar; unsigned x;
    volatile LAS unsigned* st;
};

__device__ __forceinline__ XcdBarrier xcd_barrier_post(unsigned* bar, volatile LAS unsigned* st) {
    XcdBarrier b; b.bar = bar; b.x = xb_xcc_id(); b.st = st;
    if (threadIdx.x == 0) (void)xb_add(&bar[XB_XCNT(b.x)], 1u);
    return b;
}
__device__ __forceinline__ void xcd_barrier_complete(unsigned* bar, unsigned x, unsigned& nloc, unsigned& nx) {
    const unsigned G = gridDim.x * gridDim.y * gridDim.z;
    unsigned sum, cnt, mine, sp = 0u;
    for (;;) {
        sum = 0u; cnt = 0u; mine = 0u;
#pragma unroll
        for (unsigned j = 0; j < 16; ++j) { const unsigned c = xb_ld(&bar[XB_XCNT(j)]); sum += c; cnt += (c > 0u) ? 1u : 0u; mine = (j == x) ? c : mine; }
        if (sum == G) break;
        __builtin_amdgcn_s_sleep(1);
        if ((++sp & 255u) == 0u) { if (xb_ld(&bar[XB_TMO])) break; if (sp > XB_SPIN_CAP) { atomicAdd(&bar[XB_TMO], 1u); break; } }
    }
    nloc = mine > 0u ? mine : 1u; nx = cnt > 0u ? cnt : 1u;
}

__device__ __forceinline__ void xcd_barrier(const XcdBarrier& b) {
    asm volatile("s_waitcnt vmcnt(0)" ::: "memory");
    __syncthreads();
    if (threadIdx.x == 0) {
        unsigned* bar = b.bar;
        __builtin_amdgcn_s_waitcnt(0);
        unsigned nloc = b.st[0], nx = b.st[1];
        if (nloc == 0u) { xcd_barrier_complete(bar, b.x, nloc, nx); b.st[0] = nloc; b.st[1] = nx; }
        const unsigned old = xb_add(&bar[XB_XSUB(b.x)], 1u);
        const unsigned gen = old / nloc;
        if (old + 1u == (gen + 1u) * nloc) {
            __builtin_amdgcn_fence(__ATOMIC_RELEASE, "agent");
            asm volatile("s_waitcnt vmcnt(0)" ::: "memory");
            const unsigned og = xb_add(&bar[XB_TOP], 1u);
            const unsigned tg = og / nx;
            if (og + 1u == (tg + 1u) * nx) xb_add(&bar[XB_TOPGEN], 1u);
            else XB_SPIN(xb_ld(&bar[XB_TOPGEN]) == tg, bar);
            __builtin_amdgcn_fence(__ATOMIC_ACQUIRE, "agent");
            xb_add(&bar[XB_XGEN(b.x)], 1u);
            asm volatile("s_waitcnt vmcnt(0)" ::: "memory");
        } else {
            XB_SPIN(xb_ld(&bar[XB_XGEN(b.x)]) == gen, bar);
            __builtin_amdgcn_fence(__ATOMIC_ACQUIRE, "agent");
            asm volatile("s_waitcnt vmcnt(0)" ::: "memory");
        }
    }
    __syncthreads();
}
constexpr int NWAVES = 8, NTHR = 512;
constexpr int BATCH = 8, SEQ = 2048, D = 1024, M = BATCH * SEQ, DFF = 2816, NFF = 2 * DFF, NMOD = 9 * D;
constexpr int INC = 2832, PROJW = 3072;
constexpr int P_GQ = 0, P_GK = 192, P_GV = 384, P_GG = 768, P_SQ = 1152, P_SK = 1536, P_SV = 1920, P_CUA = 2304, P_CUG = 2560, P_GR = 2816;
constexpr float EPS = 1e-6f;
constexpr int NPL = 12, NPH = 1 + 2 * NPL;

constexpr size_t MiB = 1u << 20;
constexpr size_t WS_CTL = 0, CTL_ZERO_BYTES = 1 * MiB;
constexpr size_t WS_MOD = 1 * MiB;
constexpr size_t WS_WT = 2 * MiB, WT_LAYER = 41 * MiB;
constexpr size_t WT_1A = 0, WT_1B = 11 * MiB, WT_IN = 11 * MiB + 5632 * 1024, WT_OUT = WT_IN + 6 * MiB, WT_2A = WT_OUT + 2 * MiB, WT_2B = WT_2A + 11 * MiB;
static_assert(WT_2B + 5632 * 1024 == WT_LAYER, "weight map");
constexpr size_t WS_XN = 84 * MiB;
constexpr size_t WS_U = 116 * MiB;
constexpr size_t WS_LOGA = 212 * MiB;
constexpr size_t WS_GLARAW = 224 * MiB;
constexpr size_t WS_END = 248 * MiB;
static_assert(WS_WT + 2 * WT_LAYER == WS_XN && WS_XN + (size_t)M * D * 2 == WS_U && WS_U + (size_t)M * PROJW * 2 == WS_LOGA && WS_LOGA + (size_t)M * 192 * 4 == WS_GLARAW && WS_GLARAW + (size_t)M * 384 * 4 == WS_END, "d_ws map");
constexpr int CW_BAR = 4096;

constexpr int RING_OFF = 0, RING_BYTES = 131072;
constexpr int LDSCTL_OFF = RING_BYTES, MISC_OFF = LDSCTL_OFF + 320;
constexpr int LDS_BYTES = 147456;
struct Args { const float* in[23]; float* out; unsigned char* ws; int ph_lo, ph_hi; };
struct Frame {
    LAS unsigned char* lds;
    volatile LAS unsigned* MISC;
    gu32* ctl;
    int tid, lane, wave, G;
    float* out; unsigned char* ws;
    float* MOD; bf16* XN; bf16* U; bf16* PROJ; float* LOGA; float* GLARAW;
};
__device__ __forceinline__ float bf2f(unsigned short v) { return __builtin_bit_cast(float, (unsigned)v << 16); }
__device__ __forceinline__ float bflo(unsigned w) { return __builtin_bit_cast(float, w << 16); }
__device__ __forceinline__ float bfhi(unsigned w) { return __builtin_bit_cast(float, w & 0xffff0000u); }
__device__ __forceinline__ float wave_sum(float v) {
#pragma unroll
    for (int o = 1; o < 64; o <<= 1) v += __shfl_xor(v, o);
    return v;
}
__device__ __forceinline__ float softplus_acc(float z) { return fmaxf(z, 0.f) + log1pf(expf(-fabsf(z))); }
__device__ __forceinline__ float silu_acc(float a) { return a / (1.0f + expf(-a)); }
__device__ __forceinline__ bf16* wt_ptr(Frame& F, int l, size_t off) { return (bf16*)(F.ws + WS_WT + (size_t)l * WT_LAYER + off); }

__device__ __forceinline__ void tr_item(const float* W, int ldw, int src_col0, int nvalid, bf16* WT, int ldk, int dest_row0, int k0, LAS float* scr, int lane) {
    const int nn = lane & 31;
    if (nvalid == 32) {
#pragma unroll 8
        for (int i = 0; i < 32; ++i) { const int kk = 2 * i + (lane >> 5); scr[kk * 33 + nn] = W[(size_t)(k0 + kk) * ldw + src_col0 + nn]; }
    } else {
        const bool ok = nn < nvalid;
#pragma unroll 8
        for (int i = 0; i < 32; ++i) { const int kk = 2 * i + (lane >> 5); float v = 0.f; if (ok) v = W[(size_t)(k0 + kk) * ldw + src_col0 + nn]; scr[kk * 33 + nn] = v; }
    }
    LDS_WAIT(); asm volatile("" ::: "memory");
    const int c = lane & 7;
#pragma unroll
    for (int j = 0; j < 4; ++j) { const int n = (lane >> 3) + 8 * j; const LAS float* s = scr + (8 * c) * 33 + n;
        v4u o; o.x = pk2(s[0 * 33], s[1 * 33]); o.y = pk2(s[2 * 33], s[3 * 33]); o.z = pk2(s[4 * 33], s[5 * 33]); o.w = pk2(s[6 * 33], s[7 * 33]);
        *(v4u*)(WT + (size_t)(dest_row0 + n) * ldk + k0 + 8 * c) = o; }
    LDS_WAIT(); asm volatile("" ::: "memory");
}
constexpr int I_A = 16 * 176, I_B = 44 * 32, I_IN = 16 * 96, I_OUT = 16 * 32, I_LAYER = 2 * I_A + 2 * I_B + I_IN + I_OUT;
__device__ __forceinline__ void tr_swiglu(Frame& F, const float* W, bf16* WT, int r, LAS float* scr) {
    const int kb = r / 176, g = r % 176, pn = g >> 3, r8 = g & 7;
    const int src = (r8 < 4) ? 128 * pn + 32 * r8 : DFF + 128 * pn + 32 * (r8 - 4);
    tr_item(W, NFF, src, 32, WT, D, 32 * g, 64 * kb, scr, F.lane);
}
__device__ __forceinline__ void tr_plain(Frame& F, const float* W, int K, int N, bf16* WT, int r, LAS float* scr) {
    const int ng = N / 32, kb = r / ng, g = r % ng;
    tr_item(W, N, 32 * g, 32, WT, K, 32 * g, 64 * kb, scr, F.lane);
}
__device__ __forceinline__ void tr_inproj(Frame& F, const float* W, bf16* WT, int r, LAS float* scr) {
    const int kb = r / 96, g = r % 96, d0 = 32 * g;
    int src = d0, nv = 32;
    if (d0 >= 1152 && d0 < 2816) src = d0 + 16; else if (d0 == 2816) { src = 1152; nv = 16; } else if (d0 > 2816) { src = 0; nv = 0; }
    tr_item(W, INC, src, nv, WT, D, d0, 64 * kb, scr, F.lane);
}
__device__ __forceinline__ void p0_prologue(Frame& F, const Args& A) {
    LAS float* cact = (LAS float*)(F.lds);
    LAS float* part = (LAS float*)(F.lds + 32768);
    const float* c = A.in[1];
    for (int i = F.tid; i < BATCH * D; i += NTHR) cact[i] = silu_acc(c[i]);
    __syncthreads();
    for (int item = blockIdx.x; item < 2 * 144; item += F.G) {
        const int l = item / 144, n0 = (item % 144) * 64;
        const float* W = A.in[2] + (size_t)l * D * NMOD;
        const int kk = F.lane >> 4, c4 = (F.lane & 15) * 4;
        float acc[8][4];
#pragma unroll
        for (int b = 0; b < 8; ++b)
#pragma unroll
            for (int j = 0; j < 4; ++j) acc[b][j] = 0.f;
#pragma unroll 8
        for (int i = 0; i < 32; ++i) {
            const int k = F.wave * 128 + i * 4 + kk;
            const f32x4 w = *(const f32x4*)(W + (size_t)k * NMOD + n0 + c4);
#pragma unroll
            for (int b = 0; b < 8; ++b) { const float cv = cact[b * D + k];
#pragma unroll
                for (int j = 0; j < 4; ++j) acc[b][j] += cv * w[j]; }
        }
#pragma unroll
        for (int b = 0; b < 8; ++b)
#pragma unroll
            for (int j = 0; j < 4; ++j) { float v = acc[b][j]; v += __shfl_xor(v, 16); v += __shfl_xor(v, 32); acc[b][j] = v; }
        if (kk == 0) {
#pragma unroll
            for (int b = 0; b < 8; ++b)
#pragma unroll
                for (int j = 0; j < 4; ++j) part[(F.wave * 8 + b) * 64 + c4 + j] = acc[b][j];
        }
        __syncthreads();
        { const int b = F.tid >> 6, col = F.tid & 63; float s = A.in[3][l * NMOD + n0 + col];
#pragma unroll
            for (int w = 0; w < 8; ++w) s += part[(w * 8 + b) * 64 + col];
            F.MOD[(size_t)(l * 8 + b) * NMOD + n0 + col] = s; }
        __syncthreads();
    }
    LAS float* scr = (LAS float*)(F.lds + F.wave * 16384);
    const int gw = blockIdx.x * NWAVES + F.wave, NGW = F.G * NWAVES;
    for (int it = gw; it < 2 * I_LAYER; it += NGW) {
        const int l = it / I_LAYER; int r = it % I_LAYER;
        if (r < I_A) { tr_swiglu(F, A.in[5] + (size_t)l * D * NFF, wt_ptr(F, l, WT_1A), r, scr); continue; } r -= I_A;
        if (r < I_B) { tr_plain(F, A.in[6] + (size_t)l * DFF * D, DFF, D, wt_ptr(F, l, WT_1B), r, scr); continue; } r -= I_B;
        if (r < I_IN) { tr_inproj(F, A.in[8] + (size_t)l * D * INC, wt_ptr(F, l, WT_IN), r, scr); continue; } r -= I_IN;
        if (r < I_OUT) { tr_plain(F, A.in[9] + (size_t)l * D * D, D, D, wt_ptr(F, l, WT_OUT), r, scr); continue; } r -= I_OUT;
        if (r < I_A) { tr_swiglu(F, A.in[21] + (size_t)l * D * NFF, wt_ptr(F, l, WT_2A), r, scr); continue; } r -= I_A;
        tr_plain(F, A.in[22] + (size_t)l * DFF * D, DFF, D, wt_ptr(F, l, WT_2B), r, scr);
    }
}

__device__ __forceinline__ void norm_phase(Frame& F, const float* xsrc, const float* gain, const float* modl, int jsh) {
    const int gw = blockIdx.x * NWAVES + F.wave, NGW = F.G * NWAVES;
    for (int m = gw; m < M; m += NGW) {
        const float* sh = modl + (size_t)(m >> 11) * NMOD + jsh * D; const float* sc = sh + D;
        const f32x4* xr = (const f32x4*)(xsrc + (size_t)m * D) + F.lane;
        f32x4 v[4]; float s = 0.f;
#pragma unroll
        for (int j = 0; j < 4; ++j) { v[j] = xr[64 * j]; s += (v[j].x * v[j].x + v[j].y * v[j].y) + (v[j].z * v[j].z + v[j].w * v[j].w); }
        const float rstd = 1.0f / sqrtf(wave_sum(s) * (1.f / D) + EPS);
        unsigned long long* o8 = (unsigned long long*)(F.XN + (size_t)m * D) + F.lane;
#pragma unroll
        for (int j = 0; j < 4; ++j) {
            const f32x4 g4 = ((const f32x4*)gain)[F.lane + 64 * j], s4 = ((const f32x4*)sc)[F.lane + 64 * j], h4 = ((const f32x4*)sh)[F.lane + 64 * j];
            const f32x4 y = v[j] * rstd * g4 * (s4 + 1.0f) + h4;
            o8[64 * j] = (unsigned long long)pk2(y.x, y.y) | ((unsigned long long)pk2(y.z, y.w) << 32);
        }
    }
}
__device__ __forceinline__ void mix_prepass(Frame& F, const Args& A, int l) {
    const int gid = blockIdx.x * NTHR + F.tid, NT = F.G * NTHR;
    const float* gq = A.in[13] + l * 64; const float* gk = A.in[14] + l * 64;
    for (int idx = gid; idx < M * 12; idx += NT) {
        const int m = idx / 12, s = idx % 12;
        bf16* p = F.PROJ + (size_t)m * PROJW + (s < 6 ? P_SQ + 64 * s : P_SK + 64 * (s - 6));
        const float* gn = s < 6 ? gq : gk; const float post = s < 6 ? 0.125f : 1.0f;
        v4u w[8]; float ss = 0.f;
#pragma unroll
        for (int i = 0; i < 8; ++i) { w[i] = ((const v4u*)p)[i];
#pragma unroll
            for (int e = 0; e < 4; ++e) { const float a = bflo(w[i][e]), b = bfhi(w[i][e]); ss += a * a + b * b; } }
        const float r = post / sqrtf(ss * (1.f / 64.f) + EPS);
#pragma unroll
        for (int i = 0; i < 8; ++i) { v4u o;
#pragma unroll
            for (int e = 0; e < 4; ++e) o[e] = pk2(bflo(w[i][e]) * r * gn[8 * i + 2 * e], bfhi(w[i][e]) * r * gn[8 * i + 2 * e + 1]);
            ((v4u*)p)[i] = o; }
    }
    const float* Wup = A.in[10] + l * 16 * 192; const float* bg = A.in[11] + l * 192;
    for (int idx = gid; idx < M * 192; idx += NT) {
        const int m = idx / 192, j = idx % 192;
        const bf16* gr = F.PROJ + (size_t)m * PROJW + P_GR;
        float x = bg[j];
#pragma unroll
        for (int r = 0; r < 16; ++r) x += bf2f(gr[r]) * Wup[r * 192 + j];
        F.LOGA[idx] = -softplus_acc(-x) * (1.0f / 16.0f);
    }
}
__device__ __forceinline__ void mix_naive(Frame& F, const Args& A, int l) {
    const int blk = blockIdx.x;
    if (blk < 192) {
        const int gid = blk * NTHR + F.tid, bh = gid >> 11, t = gid & 2047, b = bh / 6, h = bh % 6;
        const bf16* base = F.PROJ + (size_t)b * SEQ * PROJW + h * 64;
        float q[64], o[64];
        { const v4u* qp = (const v4u*)(base + (size_t)t * PROJW + P_SQ);
#pragma unroll
            for (int i = 0; i < 8; ++i) { const v4u w = qp[i];
#pragma unroll
                for (int e = 0; e < 4; ++e) { q[8 * i + 2 * e] = bflo(w[e]); q[8 * i + 2 * e + 1] = bfhi(w[e]); } } }
#pragma unroll
        for (int d = 0; d < 64; ++d) o[d] = 0.f;
        float C = 0.f;
        const int t0 = __builtin_amdgcn_readfirstlane(t & ~63);
        for (int s = t0 + 62; s >= 0; --s) {
            const v4u* kp = (const v4u*)(base + (size_t)s * PROJW + P_SK); const v4u* vp = (const v4u*)(base + (size_t)s * PROJW + P_SV);
            float z = 0.f;
#pragma unroll
            for (int i = 0; i < 8; ++i) { const v4u w = kp[i];
#pragma unroll
                for (int e = 0; e < 4; ++e) { z += q[8 * i + 2 * e] * bflo(w[e]); z += q[8 * i + 2 * e + 1] * bfhi(w[e]); } }
            if (s < t) {
                const float lk = -softplus_acc(z);
                const float wgt = expf(z + lk + C);
                C += lk;
#pragma unroll
                for (int i = 0; i < 8; ++i) { const v4u w = vp[i];
#pragma unroll
                    for (int e = 0; e < 4; ++e) { o[8 * i + 2 * e] += wgt * bflo(w[e]); o[8 * i + 2 * e + 1] += wgt * bfhi(w[e]); } }
            }
        }
        float ss = 0.f;
#pragma unroll
        for (int d = 0; d < 64; ++d) ss += o[d] * o[d];
        const float r = 1.0f / sqrtf(ss * (1.f / 64.f) + EPS);
        const float* gn = A.in[15] + l * 64;
        v4u* op = (v4u*)(F.XN + (size_t)(b * SEQ + t) * D + 384 + h * 64);
#pragma unroll
        for (int i = 0; i < 8; ++i) { v4u w;
#pragma unroll
            for (int e = 0; e < 4; ++e) w[e] = pk2(o[8 * i + 2 * e] * r * gn[8 * i + 2 * e], o[8 * i + 2 * e + 1] * r * gn[8 * i + 2 * e + 1]);
            op[i] = w; }
    } else if (blk < 198) {
        const int id = (blk - 192) * NTHR + F.tid, bh = id / 96, dv = id % 96, b = bh >> 2, h = bh & 3;
        float S[48];
#pragma unroll
        for (int k = 0; k < 48; ++k) S[k] = 0.f;
        for (int t = 0; t < SEQ; ++t) {
            const size_t m = (size_t)b * SEQ + t;
            const bf16* row = F.PROJ + m * PROJW; const float* la = F.LOGA + m * 192 + h * 48;
            const float vv = bf2f(row[P_GV + h * 96 + dv]);
            float o = 0.f;
#pragma unroll
            for (int k = 0; k < 48; ++k) { const float a = expf(la[k]); S[k] = a * S[k] + bf2f(row[P_GK + h * 48 + k]) * vv; o += bf2f(row[P_GQ + h * 48 + k]) * S[k]; }
            F.GLARAW[m * 384 + h * 96 + dv] = o * 0.14433756729740643f;
        }
    } else {
        const int cw = (blk - 198) * NWAVES + F.wave, ch = 4 * F.lane;
        const float* cwt = A.in[16] + l * 31 * 256; const float* cb = A.in[17] + l * 256; const float* lg = A.in[18] + l * 256; const float* lb = A.in[19] + l * 256;
        for (int m = cw; m < M; m += 58 * NWAVES) {
            const int t = m & 2047;
            float acc[4];
#pragma unroll
            for (int e = 0; e < 4; ++e) acc[e] = cb[ch + e];
            for (int j = 0; j < 31; ++j) { const int tt = t - 30 + j;
                if (tt >= 0) { const bf16* row = F.PROJ + (size_t)(m - 30 + j) * PROJW;
                    const unsigned long long aw = *(const unsigned long long*)(row + P_CUA + ch), gw2 = *(const unsigned long long*)(row + P_CUG + ch);
#pragma unroll
                    for (int e = 0; e < 4; ++e) { const float a = bf2f((unsigned short)(aw >> (16 * e))), g = bf2f((unsigned short)(gw2 >> (16 * e)));
                        acc[e] += cwt[j * 256 + ch + e] * (a / (1.0f + expf(-g))); } } }
            const float mean = wave_sum((acc[0] + acc[1]) + (acc[2] + acc[3])) * (1.f / 256.f);
            float q = 0.f;
#pragma unroll
            for (int e = 0; e < 4; ++e) { acc[e] -= mean; q += acc[e] * acc[e]; }
            const float rstd = 1.0f / sqrtf(wave_sum(q) * (1.f / 256.f) + EPS);
            float y[4];
#pragma unroll
            for (int e = 0; e < 4; ++e) y[e] = silu_acc(acc[e] * rstd * lg[ch + e] + lb[ch + e]);
            *(unsigned long long*)(F.XN + (size_t)m * D + 768 + ch) = (unsigned long long)pk2(y[0], y[1]) | ((unsigned long long)pk2(y[2], y[3]) << 32);
        }
    }
}
__device__ __forceinline__ void gla_finalize(Frame& F, const Args& A, int l) {
    const int gw = blockIdx.x * NWAVES + F.wave, NGW = F.G * NWAVES;
    const float* gn = A.in[12] + l * 96;
    for (int m = gw; m < M; m += NGW) {
        const float* src = F.GLARAW + (size_t)m * 384 + 6 * F.lane;
        float v[6]; float ss = 0.f;
#pragma unroll
        for (int j = 0; j < 6; ++j) { v[j] = src[j]; ss += v[j] * v[j]; }
        ss += __shfl_xor(ss, 1); ss += __shfl_xor(ss, 2); ss += __shfl_xor(ss, 4); ss += __shfl_xor(ss, 8);
        const float r = 1.0f / sqrtf(ss * (1.f / 96.f) + EPS);
        const bf16* gg = F.PROJ + (size_t)m * PROJW + P_GG + 6 * F.lane;
        unsigned* op = (unsigned*)(F.XN + (size_t)m * D + 6 * F.lane);
        const int dv0 = 6 * (F.lane & 15);
#pragma unroll
        for (int j = 0; j < 6; j += 2) op[j >> 1] = pk2(v[j] * r * gn[dv0 + j] * silu_acc(bf2f(gg[j])), v[j + 1] * r * gn[dv0 + j + 1] * silu_acc(bf2f(gg[j + 1])));
    }
}
#ifndef MK_SINGLE
#define MK_SINGLE 1
#endif
#define IN(k) (lo <= (k) && (k) < hi)
#define SEAM(k) do { if (MK_SINGLE && IN((k) + 1)) xcd_barrier(bar); } while (0)
template <int l> __device__ __forceinline__ void layer_phases(Frame& F, const Args& A, const XcdBarrier& bar, const int lo, const int hi) {
        const int pb = 1 + l * NPL;
        const float* modl = F.MOD + (size_t)l * 8 * NMOD;
        const float* xfirst = (l == 0) ? A.in[0] : F.out;
        if (IN(pb + 0)) { norm_phase(F, xfirst, A.in[4] + l * D, modl, 0); SEAM(pb + 0); }
        if (IN(pb + 1)) { pg8::Gemm g{F.XN, wt_ptr(F, l, WT_1A), M, NFF, D}; pg8::StaticOrder S; S.init(M, NFF, F.G, (int)blockIdx.x);
            pg8::EpiSwiGLU E{F.U, DFF}; pg8::gemm_phase<pg8::EpiSwiGLU, pg8::StaticOrder, true, true>(F.lds + RING_OFF, g, S, E); SEAM(pb + 1); }
        if (IN(pb + 2)) { pg8::Gemm g{F.U, wt_ptr(F, l, WT_1B), M, D, DFF}; pg8::StaticOrder S; S.init(M, D, F.G, (int)blockIdx.x);
            pg8::EpiResid E{xfirst, F.out, modl + 2 * D, 0.5f}; pg8::gemm_phase<pg8::EpiResid, pg8::StaticOrder, true, true>(F.lds + RING_OFF, g, S, E); SEAM(pb + 2); }
        if (IN(pb + 3)) { norm_phase(F, F.out, A.in[7] + l * D, modl, 3); SEAM(pb + 3); }
        if (IN(pb + 4)) { pg8::Gemm g{F.XN, wt_ptr(F, l, WT_IN), M, PROJW, D}; pg8::StaticOrder S; S.init(M, PROJW, F.G, (int)blockIdx.x);
            pg8::EpiBf16<0> E{F.PROJ, PROJW, nullptr, 0, 0, 1.f}; pg8::gemm_phase<pg8::EpiBf16<0>, pg8::StaticOrder, true, true>(F.lds + RING_OFF, g, S, E); SEAM(pb + 4); }
        if (IN(pb + 5)) { mix_prepass(F, A, l); SEAM(pb + 5); }
        if (IN(pb + 6)) { mix_naive(F, A, l); SEAM(pb + 6); }
        if (IN(pb + 7)) { gla_finalize(F, A, l); SEAM(pb + 7); }
        if (IN(pb + 8)) { pg8::Gemm g{F.XN, wt_ptr(F, l, WT_OUT), M, D, D}; pg8::StaticOrder S; S.init(M, D, F.G, (int)blockIdx.x);
            pg8::EpiResid E{F.out, F.out, modl + 5 * D, 1.0f}; pg8::gemm_phase<pg8::EpiResid, pg8::StaticOrder, true, true>(F.lds + RING_OFF, g, S, E); SEAM(pb + 8); }
        if (IN(pb + 9)) { norm_phase(F, F.out, A.in[20] + l * D, modl, 6); SEAM(pb + 9); }
        if (IN(pb + 10)) { pg8::Gemm g{F.XN, wt_ptr(F, l, WT_2A), M, NFF, D}; pg8::StaticOrder S; S.init(M, NFF, F.G, (int)blockIdx.x);
            pg8::EpiSwiGLU E{F.U, DFF}; pg8::gemm_phase<pg8::EpiSwiGLU, pg8::StaticOrder, true, true>(F.lds + RING_OFF, g, S, E); SEAM(pb + 10); }
        if (IN(pb + 11)) { pg8::Gemm g{F.U, wt_ptr(F, l, WT_2B), M, D, DFF}; pg8::StaticOrder S; S.init(M, D, F.G, (int)blockIdx.x);
            pg8::EpiResid E{F.out, F.out, modl + 8 * D, 0.5f}; pg8::gemm_phase<pg8::EpiResid, pg8::StaticOrder, true, true>(F.lds + RING_OFF, g, S, E); SEAM(pb + 11); }
}
__global__ void __launch_bounds__(NTHR, 2) mk_fwd(Args A) {
    extern __shared__ __attribute__((aligned(16))) unsigned char lds[];
    Frame F;
    F.lds = (LAS unsigned char*)lds;
    F.MISC = (volatile LAS unsigned*)(F.lds + MISC_OFF);
    F.tid = threadIdx.x; F.lane = F.tid & 63; F.wave = __builtin_amdgcn_readfirstlane(F.tid >> 6);
    F.G = gridDim.x;
    F.out = A.out; F.ws = A.ws;
    F.ctl = (gu32*)(A.ws + WS_CTL);
    F.MOD = (float*)(A.ws + WS_MOD); F.XN = (bf16*)(A.ws + WS_XN); F.U = (bf16*)(A.ws + WS_U); F.PROJ = (bf16*)(A.ws + WS_U);
    F.LOGA = (float*)(A.ws + WS_LOGA); F.GLARAW = (float*)(A.ws + WS_GLARAW);
    for (int u = F.tid; u < (LDS_BYTES - LDSCTL_OFF) / 4; u += NTHR) ((LAS unsigned*)(F.lds + LDSCTL_OFF))[u] = 0u;
    __syncthreads();
    XcdBarrier bar; bar.bar = (unsigned*)(F.ctl + CW_BAR); bar.x = 0; bar.st = nullptr;
    if (MK_SINGLE) bar = xcd_barrier_post((unsigned*)(F.ctl + CW_BAR), F.MISC + 8);
    const int lo = A.ph_lo, hi = A.ph_hi;

    if (IN(0)) { p0_prologue(F, A); SEAM(0); }
    layer_phases<0>(F, A, bar, lo, hi);
    layer_phases<1>(F, A, bar, lo, hi);
#undef IN
#undef SEAM
}

extern "C" void kernel_launch(void* const* d_in, const int* in_sizes, int n_in, void* d_out, int out_size, void* d_ws, size_t ws_size, hipStream_t stream) {
    static int grid = 0;
    if (grid == 0) {
        if (n_in != 23 || in_sizes[0] != M * D || out_size != M * D || ws_size < WS_END) { fprintf(stderr, "kernel_launch: unexpected shapes (n_in %d, in0 %d, out %d, ws %zu); nothing launched\n", n_in, n_in > 0 ? in_sizes[0] : -1, out_size, ws_size); grid = -1; return; }
        int dev = 0, cus = 0, per_cu = 0;
        if (hipGetDevice(&dev) != hipSuccess || hipDeviceGetAttribute(&cus, hipDeviceAttributeMultiprocessorCount, dev) != hipSuccess) { grid = -1; return; }
        if (hipFuncSetAttribute((const void*)mk_fwd, hipFuncAttributeMaxDynamicSharedMemorySize, LDS_BYTES) != hipSuccess) { fprintf(stderr, "kernel_launch: hipFuncSetAttribute failed\n"); grid = -1; return; }
        if (hipOccupancyMaxActiveBlocksPerMultiprocessor(&per_cu, (const void*)mk_fwd, NTHR, LDS_BYTES) != hipSuccess || per_cu < 1) { fprintf(stderr, "kernel_launch: occupancy query says %d blocks per CU\n", per_cu); (void)hipGetLastError(); grid = -1; return; }
        grid = cus;
        if (grid != 256) { fprintf(stderr, "kernel_launch: built for 256 CUs, device has %d\n", cus); grid = -1; return; }
    }
    if (grid < 0) return;
    if (hipMemsetAsync((char*)d_ws + WS_CTL, 0, CTL_ZERO_BYTES, stream) != hipSuccess) return;
    Args a{};
    for (int i = 0; i < 23; ++i) a.in[i] = (const float*)d_in[i];
    a.out = (float*)d_out; a.ws = (unsigned char*)d_ws;
#if MK_SINGLE
    a.ph_lo = 0; a.ph_hi = NPH;
    hipLaunchKernelGGL(mk_fwd, dim3(grid), dim3(NTHR), LDS_BYTES, stream, a);
#else
    for (int p = 0; p < NPH; ++p) { a.ph_lo = p; a.ph_hi = p + 1; hipLaunchKernelGGL(mk_fwd, dim3(grid), dim3(NTHR), LDS_BYTES, stream, a); }
#endif
}
```

```cpp
#include <hip/hip_runtime.h>
#include <cstdio>
#include <cstdint>
#include <cmath>
namespace pg8 {
#define PG8_LAS __attribute__((address_space(3)))
typedef unsigned short bf16_t;
typedef short bf16x8 __attribute__((ext_vector_type(8)));
typedef float f32x4 __attribute__((ext_vector_type(4)));
typedef unsigned u32x4 __attribute__((ext_vector_type(4)));
constexpr int BM = 256, BK = 64, HALF = 128, HTB = HALF * BK * 2  , STAGE_BYTES = 8 * HTB, NXCD = 8, WGM = 8;

__host__ __device__ __forceinline__ int lds_byte(int r, int c) { const int st = (r >> 4) * 2 + (c >> 5), rr = r & 15, cc = c & 31, ob = rr * 64 + cc * 2; return st * 1024 + (ob ^ (((ob >> 9) & 1) << 5)); }
__host__ __device__ __forceinline__ void stage_rc(int b, int& R, int& C) { const int st = b / 1024, sb = b % 1024, swz = sb ^ (((sb >> 9) & 1) << 5); R = (st >> 1) * 16 + swz / 64; C = (st & 1) * 32 + (swz % 64) / 2; }
__host__ __device__ __forceinline__ int perm32(int rho) { const int n = rho >> 4, i = rho & 15; return 8 * (i >> 2) + 4 * n + (i & 3); }

struct Unit { int pm, pn; };
struct Gemm { const bf16_t* A; const bf16_t* Bt; int M, N, K; };

struct StaticOrder {
    int nM, nN, nwg, G, c;
    __host__ __device__ void init(int M, int N, int G_, int c_) { nM = M / BM; nN = N / BM; nwg = nM * nN; G = G_; c = c_; }
    __host__ __device__ bool next(int i, Unit& u) const {
        const long L = (long)i * G + c; if (L >= nwg) return false;
        int wgid = (int)L; { const int q = nwg / NXCD, r = nwg % NXCD, xcd = wgid % NXCD, off = wgid / NXCD; wgid = (xcd < r ? xcd * (q + 1) : r * (q + 1) + (xcd - r) * q) + off; }
        const int nig = WGM * nN, gid = wgid / nig, fm = gid * WGM, gsz = (nM - fm) < WGM ? (nM - fm) : WGM;
        u.pm = fm + ((wgid % nig) % gsz); u.pn = (wgid % nig) / gsz; return true;
    }
    __device__ __forceinline__ void a_ready(const Unit&) const {}
    __device__ __forceinline__ void done(const Unit&) const {}
};

__device__ __forceinline__ unsigned cvt_pk_bf16(float lo, float hi) { unsigned r; asm volatile("v_cvt_pk_bf16_f32 %0, %1, %2" : "=v"(r) : "v"(lo), "v"(hi)); return r; }
typedef float f32x2 __attribute__((ext_vector_type(2)));
__device__ __forceinline__ f32x2 gelu_pk(f32x2 v) {
    const f32x2 av = __builtin_elementwise_abs(v), d = av * 0.2316418882f + 1.0f;
    f32x2 t; t.x = __builtin_amdgcn_rcpf(d.x); t.y = __builtin_amdgcn_rcpf(d.y);
    f32x2 q = t * 0.5307027145f + (-0.7265760135f); q = q * t + 0.7107068705f; q = q * t + (-0.142248368f); q = q * t + 0.127414796f; q = q * t;
    const f32x2 s = (v * v) * (-0.72134752044f);
    f32x2 e; e.x = __builtin_amdgcn_exp2f(s.x); e.y = __builtin_amdgcn_exp2f(s.y);
    const f32x2 m = v * (q * e), r = v - m;
    f32x2 o; o.x = v.x < 0.f ? m.x : r.x; o.y = v.y < 0.f ? m.y : r.y; return o;
}

template <int ACT  > struct EpiBf16 {
    static constexpr bool PERM = true, AFTER_DRAIN = false; static_assert(ACT == 0 || ACT == 1, "EpiBf16: ACT is 0 (none) or 1 (gelu_pk)");
    bf16_t* O; int ldc; const float* bias; int split_cols; size_t split_stride; float scale0;
    __device__ __forceinline__ void operator()(const f32x4 (&acc)[2][2][4][2], const Unit& u, int wr, int wc, int fr, int fq) const {
        const int row0 = u.pm * BM + wr * 64 + fr; int colt = u.pn * BM; bf16_t* base = O;
        float sc = 1.f; if (split_cols) { const int t = colt / split_cols; base += (size_t)t * split_stride; colt -= t * split_cols; if (t == 0) sc = scale0; }
        const int col0 = colt + wc * 32 + 8 * fq, bcol0 = u.pn * BM + wc * 32 + 8 * fq;
        f32x4 bv[2][2];
#pragma unroll
        for (int bj = 0; bj < 2; ++bj)
#pragma unroll
            for (int n = 0; n < 2; ++n) bv[bj][n] = bias ? *(const f32x4*)(bias + bcol0 + bj * HALF + 4 * n) : (f32x4){0.f, 0.f, 0.f, 0.f};
#pragma unroll
        for (int ai = 0; ai < 2; ++ai)
#pragma unroll
            for (int m = 0; m < 4; ++m) { bf16_t* rowp = base + (size_t)(row0 + ai * HALF + m * 16) * ldc + col0;
#pragma unroll
                for (int bj = 0; bj < 2; ++bj) { f32x4 v0 = acc[ai][bj][m][0] + bv[bj][0], v1 = acc[ai][bj][m][1] + bv[bj][1];
                    if (ACT == 1) { f32x2 a = gelu_pk((f32x2){v0[0], v0[1]}), b = gelu_pk((f32x2){v0[2], v0[3]}), c = gelu_pk((f32x2){v1[0], v1[1]}), d = gelu_pk((f32x2){v1[2], v1[3]});
                        v0 = (f32x4){a.x, a.y, b.x, b.y}; v1 = (f32x4){c.x, c.y, d.x, d.y}; }
                    v0 = v0 * sc; v1 = v1 * sc; u32x4 w; w.x = cvt_pk_bf16(v0[0], v0[1]); w.y = cvt_pk_bf16(v0[2], v0[3]); w.z = cvt_pk_bf16(v1[0], v1[1]); w.w = cvt_pk_bf16(v1[2], v1[3]);
                    *(u32x4*)(rowp + bj * HALF) = w; } }
    }
};
__device__ __forceinline__ float silu_f(float a) { return a * __builtin_amdgcn_rcpf(1.0f + __builtin_amdgcn_exp2f(-1.4426950408889634f * a)); }
struct EpiSwiGLU {
    static constexpr bool PERM = true, AFTER_DRAIN = false;
    bf16_t* O; int ldc;
    __device__ __forceinline__ void operator()(const f32x4 (&acc)[2][2][4][2], const Unit& u, int wr, int wc, int fr, int fq) const {
        const int row0 = u.pm * BM + wr * 64 + fr, col0 = u.pn * HALF + wc * 32 + 8 * fq;
#pragma unroll
        for (int ai = 0; ai < 2; ++ai)
#pragma unroll
            for (int m = 0; m < 4; ++m) { bf16_t* rowp = O + (size_t)(row0 + ai * HALF + m * 16) * ldc + col0;
                const f32x4 a0 = acc[ai][0][m][0], a1 = acc[ai][0][m][1], b0 = acc[ai][1][m][0], b1 = acc[ai][1][m][1];
                f32x4 v0, v1;
#pragma unroll
                for (int j = 0; j < 4; ++j) { v0[j] = silu_f(a0[j]) * b0[j]; v1[j] = silu_f(a1[j]) * b1[j]; }
                u32x4 w; w.x = cvt_pk_bf16(v0[0], v0[1]); w.y = cvt_pk_bf16(v0[2], v0[3]); w.z = cvt_pk_bf16(v1[0], v1[1]); w.w = cvt_pk_bf16(v1[2], v1[3]);
                *(u32x4*)rowp = w; }
    }
};
struct EpiResid {
    static constexpr bool PERM = false, AFTER_DRAIN = false;
    const float* xin; float* out; const float* gate; float fac;
    __device__ __forceinline__ void operator()(const f32x4 (&acc)[2][2][4][2], const Unit& u, int wr, int wc, int fr, int fq) const {
        const int row0 = u.pm * BM + wr * 64 + fr, col0 = u.pn * BM + wc * 32 + 4 * fq;
        const float* g = gate + (size_t)(u.pm >> 3) * 9216 + col0;
        f32x4 gv[2][2];
#pragma unroll
        for (int bj = 0; bj < 2; ++bj)
#pragma unroll
            for (int n = 0; n < 2; ++n) gv[bj][n] = *(const f32x4*)(g + bj * HALF + n * 16) * fac;
#pragma unroll
        for (int ai = 0; ai < 2; ++ai)
#pragma unroll
            for (int m = 0; m < 4; ++m) { const size_t off = (size_t)(row0 + ai * HALF + m * 16) * 1024 + col0;
#pragma unroll
                for (int bj = 0; bj < 2; ++bj)
#pragma unroll
                    for (int n = 0; n < 2; ++n) { const f32x4 xv = *(const f32x4*)(xin + off + bj * HALF + n * 16);
                        *(f32x4*)(out + off + bj * HALF + n * 16) = xv + gv[bj][n] * acc[ai][bj][m][n]; }
                asm volatile("" ::: "memory"); }
    }
};
template <class Epi, class Sched, bool ALIGN_EPI = false, bool SP2 = false>
__device__ __forceinline__ void gemm_phase(PG8_LAS unsigned char* lds, const Gemm g, const Sched& S, const Epi& E) {
    const int tid = threadIdx.x, wid = __builtin_amdgcn_readfirstlane(tid >> 6), lane = tid & 63, wr = wid >> 2, wc = wid & 3, fr = lane & 15, fq = lane >> 4;
    const int K = g.K, nt = K / BK;
    unsigned voffA[2], voffB[2];
#pragma unroll
    for (int i = 0; i < 2; ++i) { int R, C; stage_rc(tid * 16 + i * 8192, R, C); const int Rb = Epi::PERM ? ((R & ~31) + perm32(R & 31)) : R;
        voffA[i] = (unsigned)(R * K + C) * 2u; voffB[i] = (unsigned)(Rb * K + C) * 2u; }
    const size_t kstep = (size_t)(BK * 2);
    const size_t hstep = (size_t)HALF * K * 2;
    const size_t tstep = 2 * hstep;
    const unsigned ldsw = (unsigned)wid * 1024u;
    const int aoff = lds_byte(wr * 64 + fr, fq * 8), boff = lds_byte(wc * 32 + fr, fq * 8);
#define PG8_SA(b, h) (((b) * 2 + (h)) * HTB)
#define PG8_SB(b, h) ((4 + (b) * 2 + (h)) * HTB)
#define PG8_STAGE(bufoff, gbase, voff) do { _Pragma("unroll") for (int _i = 0; _i < 2; ++_i) \
        __builtin_amdgcn_global_load_lds((const unsigned*)((const char*)(gbase) + (voff)[_i]), (PG8_LAS unsigned*)(lds + (bufoff) + ldsw + _i * 8192), 16, 0, 0); } while (0)
#define PG8_LDA(dst, b, h) do { _Pragma("unroll") for (int m = 0; m < 4; ++m) _Pragma("unroll") for (int k = 0; k < 2; ++k) dst[m][k] = *(const PG8_LAS bf16x8*)(lds + PG8_SA(b, h) + aoff + m * 2048 + k * 1024); } while (0)
#define PG8_LDB(dst, b, h) do { _Pragma("unroll") for (int n = 0; n < 2; ++n) _Pragma("unroll") for (int k = 0; k < 2; ++k) dst[n][k] = *(const PG8_LAS bf16x8*)(lds + PG8_SB(b, h) + boff + n * 2048 + k * 1024); } while (0)
#define PG8_MMA(ai, bj, At, Bt) do { __builtin_amdgcn_s_setprio(1); _Pragma("unroll") for (int m = 0; m < 4; ++m) _Pragma("unroll") for (int n = 0; n < 2; ++n) _Pragma("unroll") for (int k = 0; k < 2; ++k) \
        acc[ai][bj][m][n] = __builtin_amdgcn_mfma_f32_16x16x32_bf16(Bt[n][k], At[m][k], acc[ai][bj][m][n], 0, 0, 0); __builtin_amdgcn_s_setprio(0); } while (0)
#define PG8_WAIT_V(n) asm volatile("s_waitcnt vmcnt(" #n ")" ::: "memory")
#define PG8_WAIT_L(n) asm volatile("s_waitcnt lgkmcnt(" #n ")" ::: "memory")
#define PG8_BAR __builtin_amdgcn_s_barrier()
#define PG8_SCHED __builtin_amdgcn_sched_barrier(0)
    Unit cur, nxt; int ui = 0;
    if (!S.next(0, cur)) return;
    f32x4 acc[2][2][4][2];
#pragma unroll
    for (int a = 0; a < 2; ++a)
#pragma unroll
        for (int b = 0; b < 2; ++b)
#pragma unroll
            for (int m = 0; m < 4; ++m)
#pragma unroll
                for (int n = 0; n < 2; ++n) acc[a][b][m][n] = (f32x4){0.f, 0.f, 0.f, 0.f};
    bf16x8 At[4][2], B0[2][2], B1[2][2];
    const char* cA = (const char*)g.A + (size_t)cur.pm * tstep; const char* cB = (const char*)g.Bt + (size_t)cur.pn * tstep;
    S.a_ready(cur);
    if constexpr (SP2) {
        PG8_STAGE(PG8_SB(0, 0), cB, voffB); PG8_STAGE(PG8_SB(0, 1), cB + hstep, voffB); PG8_STAGE(PG8_SA(0, 0), cA, voffA); PG8_STAGE(PG8_SA(0, 1), cA + hstep, voffA);
        if (wr == 1) PG8_BAR;
        PG8_WAIT_V(2); PG8_BAR;
        PG8_STAGE(PG8_SB(1, 0), cB + kstep, voffB); PG8_STAGE(PG8_SA(1, 0), cA + kstep, voffA); PG8_STAGE(PG8_SB(1, 1), cB + hstep + kstep, voffB);
        PG8_WAIT_V(6); PG8_BAR;
    } else {
        PG8_STAGE(PG8_SB(0, 0), cB, voffB); PG8_STAGE(PG8_SA(0, 0), cA, voffA); PG8_STAGE(PG8_SB(0, 1), cB + hstep, voffB); PG8_STAGE(PG8_SA(0, 1), cA + hstep, voffA);
        if (wr == 1) PG8_BAR;
        PG8_WAIT_V(4); PG8_BAR;
        PG8_STAGE(PG8_SB(1, 0), cB + kstep, voffB); PG8_STAGE(PG8_SA(1, 0), cA + kstep, voffA); PG8_STAGE(PG8_SB(1, 1), cB + hstep + kstep, voffB);
        PG8_WAIT_V(6); PG8_BAR;
    }
    for (;;) {
        const bool has_next = S.next(ui + 1, nxt);
        const char* nA = has_next ? (const char*)g.A + (size_t)nxt.pm * tstep : cA; const char* nB = has_next ? (const char*)g.Bt + (size_t)nxt.pn * tstep : cB;
        for (int t = 0; t < nt; t += 2) {
            const bool last = (t == nt - 2);
            const char* a1 = cA + (size_t)(t + 1) * kstep;
            const char* a2 = last ? nA : cA + (size_t)(t + 2) * kstep; const char* b2 = last ? nB : cB + (size_t)(t + 2) * kstep;
            const char* a3 = a2 + kstep; const char* b3 = b2 + kstep;
            if (last && has_next) S.a_ready(nxt);
            if constexpr (SP2) {
            PG8_LDB(B0, 0, 0); PG8_LDB(B1, 0, 1); PG8_SCHED; PG8_LDA(At, 0, 0); PG8_STAGE(PG8_SA(1, 1), a1 + hstep, voffA);
            PG8_WAIT_V(8); PG8_WAIT_L(0); PG8_BAR; PG8_MMA(0, 0, At, B0); PG8_MMA(0, 1, At, B1); PG8_BAR; PG8_SCHED;
            PG8_LDA(At, 0, 1); PG8_STAGE(PG8_SB(0, 0), b2, voffB); PG8_STAGE(PG8_SB(0, 1), b2 + hstep, voffB); PG8_STAGE(PG8_SA(0, 0), a2, voffA);
            PG8_WAIT_V(8); PG8_WAIT_L(0); PG8_BAR; PG8_MMA(1, 0, At, B0); PG8_MMA(1, 1, At, B1); PG8_BAR; PG8_SCHED;
            PG8_LDB(B0, 1, 0); PG8_LDB(B1, 1, 1); PG8_SCHED; PG8_LDA(At, 1, 0); PG8_STAGE(PG8_SA(0, 1), a2 + hstep, voffA);
            PG8_WAIT_V(8); PG8_WAIT_L(0); PG8_BAR; PG8_MMA(0, 0, At, B0); PG8_MMA(0, 1, At, B1); PG8_BAR; PG8_SCHED;
            PG8_LDA(At, 1, 1); PG8_STAGE(PG8_SB(1, 0), b3, voffB); PG8_STAGE(PG8_SB(1, 1), b3 + hstep, voffB); PG8_STAGE(PG8_SA(1, 0), a3, voffA);
            PG8_WAIT_V(8); PG8_WAIT_L(0); PG8_BAR; PG8_MMA(1, 0, At, B0); PG8_MMA(1, 1, At, B1); PG8_BAR; PG8_SCHED;
            } else {
            PG8_LDB(B0, 0, 0); PG8_SCHED; PG8_LDA(At, 0, 0); PG8_STAGE(PG8_SA(1, 1), a1 + hstep, voffA);
            PG8_WAIT_L(8); PG8_BAR; PG8_WAIT_L(0); PG8_MMA(0, 0, At, B0); PG8_BAR; PG8_SCHED;
            PG8_LDB(B1, 0, 1); PG8_STAGE(PG8_SB(0, 0), b2, voffB);
            PG8_BAR; PG8_WAIT_L(0); PG8_MMA(0, 1, At, B1); PG8_BAR;
            PG8_LDA(At, 0, 1); PG8_STAGE(PG8_SA(0, 0), a2, voffA);
            PG8_BAR; PG8_WAIT_L(0); PG8_MMA(1, 0, At, B0); PG8_BAR; PG8_SCHED;
            PG8_STAGE(PG8_SB(0, 1), b2 + hstep, voffB);
            PG8_WAIT_V(6); PG8_BAR; PG8_MMA(1, 1, At, B1); PG8_BAR;
            PG8_LDB(B0, 1, 0); PG8_SCHED; PG8_LDA(At, 1, 0); PG8_STAGE(PG8_SA(0, 1), a2 + hstep, voffA);
            PG8_WAIT_L(8); PG8_BAR; PG8_WAIT_L(0); PG8_MMA(0, 0, At, B0); PG8_BAR; PG8_SCHED;
            PG8_LDB(B1, 1, 1); PG8_STAGE(PG8_SB(1, 0), b3, voffB);
            PG8_BAR; PG8_WAIT_L(0); PG8_MMA(0, 1, At, B1); PG8_BAR;
            PG8_LDA(At, 1, 1); PG8_STAGE(PG8_SA(1, 0), a3, voffA);
            PG8_BAR; PG8_WAIT_L(0); PG8_MMA(1, 0, At, B0); PG8_BAR; PG8_SCHED;
            PG8_STAGE(PG8_SB(1, 1), b3 + hstep, voffB);
            PG8_WAIT_V(6); PG8_BAR; PG8_MMA(1, 1, At, B1); PG8_BAR;
            }
        }
        if constexpr (ALIGN_EPI) { if (wr == 0) PG8_BAR; }
        if constexpr (!Epi::AFTER_DRAIN) { E(acc, cur, wr, wc, fr, fq); S.done(cur); }
        if (!has_next) break;
#pragma unroll
        for (int a = 0; a < 2; ++a)
#pragma unroll
            for (int b = 0; b < 2; ++b)
#pragma unroll
                for (int m = 0; m < 4; ++m)
#pragma unroll
                    for (int n = 0; n < 2; ++n) acc[a][b][m][n] = (f32x4){0.f, 0.f, 0.f, 0.f};
        cur = nxt; cA = nA; cB = nB; ++ui;
        if constexpr (ALIGN_EPI) { if (wr == 1) PG8_BAR; }
    }
    PG8_WAIT_V(0);
    if constexpr (!ALIGN_EPI) { if (wr == 0) PG8_BAR; }
    PG8_BAR;
    if constexpr (Epi::AFTER_DRAIN) { E.fused(acc, cur, wr, wc, fr, fq, lds, wid, lane); S.done(cur); }
#undef PG8_SA
#undef PG8_SB
#undef PG8_STAGE
#undef PG8_LDA
#undef PG8_LDB
#undef PG8_MMA
#undef PG8_WAIT_V
#undef PG8_WAIT_L
#undef PG8_BAR
#undef PG8_SCHED
}
}
#define GAS __attribute__((address_space(1)))
#define LAS __attribute__((address_space(3)))
typedef unsigned short bf16;
typedef unsigned v4u __attribute__((ext_vector_type(4)));
typedef float f32x4 __attribute__((ext_vector_type(4)));
typedef short bf16x8 __attribute__((ext_vector_type(8)));
typedef GAS unsigned gu32;
typedef GAS unsigned long long gu64;
#define RLX_AGENT __ATOMIC_RELAXED, __HIP_MEMORY_SCOPE_AGENT
#define LDS_WAIT() asm volatile("s_waitcnt lgkmcnt(0)" ::: "memory")
#define VM_WAIT() asm volatile("s_waitcnt vmcnt(0)" ::: "memory")
__device__ __forceinline__ unsigned long long rt() { return __builtin_amdgcn_s_memrealtime(); }
__device__ __forceinline__ unsigned f2bf(float f) { unsigned u = __builtin_bit_cast(unsigned, f); return (u + 0x7fffu + ((u >> 16) & 1u)) >> 16; }
__device__ __forceinline__ unsigned pk2(float lo, float hi) { return f2bf(lo) | (f2bf(hi) << 16); }
#define XB_TMO      128
#define XB_XCNT(j)  (256  + 64 * (j))
#define XB_XSUB(j)  (1280 + 64 * (j))
#define XB_XGEN(j)  (2304 + 64 * (j))
#define XB_TOP      3328
#define XB_TOPGEN   3392
#define XCD_BAR_WORDS 3456
#define XB_SPIN_CAP (1u << 18)

__device__ __forceinline__ unsigned xb_ld(unsigned* p)              { return __hip_atomic_load(p, __ATOMIC_RELAXED, __HIP_MEMORY_SCOPE_AGENT); }
__device__ __forceinline__ unsigned xb_add(unsigned* p, unsigned v) { return __hip_atomic_fetch_add(p, v, __ATOMIC_RELAXED, __HIP_MEMORY_SCOPE_AGENT); }
__device__ __forceinline__ unsigned xb_xcc_id() { return (unsigned)__builtin_amdgcn_s_getreg((3 << 11) | 20) & 0xFu; }
#define XB_SPIN(cond, bar) do { unsigned _sp = 0; while (cond) { __builtin_amdgcn_s_sleep(1); \
    if ((++_sp & 255u) == 0u) { if (xb_ld(&(bar)[XB_TMO])) break; if (_sp > XB_SPIN_CAP) { atomicAdd(&(bar)[XB_TMO], 1u); break; } } } } while (0)

struct XcdBarrier {
    unsigned* bar; unsigned x;
    volatile LAS unsigned* st;
};

__device__ __forceinline__ XcdBarrier xcd_barrier_post(unsigned* bar, volatile LAS unsigned* st) {
    XcdBarrier b; b.bar = bar; b.x = xb_xcc_id(); b.st = st;
    if (threadIdx.x == 0) (void)xb_add(&bar[XB_XCNT(b.x)], 1u);
    return b;
}
__device__ __forceinline__ void xcd_barrier_complete(unsigned* bar, unsigned x, unsigned& nloc, unsigned& nx) {
    const unsigned G = gridDim.x * gridDim.y * gridDim.z;
    unsigned sum, cnt, mine, sp = 0u;
    for (;;) {
        sum = 0u; cnt = 0u; mine = 0u;
#pragma unroll
        for (unsigned j = 0; j < 16; ++j) { const unsigned c = xb_ld(&bar[XB_XCNT(j)]); sum += c; cnt += (c > 0u) ? 1u : 0u; mine = (j == x) ? c : mine; }
        if (sum == G) break;
        __builtin_amdgcn_s_sleep(1);
        if ((++sp & 255u) == 0u) { if (xb_ld(&bar[XB_TMO])) break; if (sp > XB_SPIN_CAP) { atomicAdd(&bar[XB_TMO], 1u); break; } }
    }
    nloc = mine > 0u ? mine : 1u; nx = cnt > 0u ? cnt : 1u;
}

__device__ __forceinline__ void xcd_barrier(const XcdBarrier& b) {
    asm volatile("s_waitcnt vmcnt(0)" ::: "memory");
    __syncthreads();
    if (threadIdx.x == 0) {
        unsigned* bar = b.bar;
        __builtin_amdgcn_s_waitcnt(0);
        unsigned nloc = b.st[0], nx = b.st[1];
        if (nloc == 0u) { xcd_barrier_complete(bar, b.x, nloc, nx); b.st[0] = nloc; b.st[1] = nx; }
        const unsigned old = xb_add(&bar[XB_XSUB(b.x)], 1u);
        const unsigned gen = old / nloc;
        if (old + 1u == (gen + 1u) * nloc) {
            __builtin_amdgcn_fence(__ATOMIC_RELEASE, "agent");
            asm volatile("s_waitcnt vmcnt(0)" ::: "memory");
            const unsigned og = xb_add(&bar[XB_TOP], 1u);
            const unsigned tg = og / nx;
            if (og + 1u == (tg + 1u) * nx) xb_add(&bar[XB_TOPGEN], 1u);
            else XB_SPIN(xb_ld(&bar[XB_TOPGEN]) == tg, bar);
            __builtin_amdgcn_fence(__ATOMIC_ACQUIRE, "agent");
            xb_add(&bar[XB_XGEN(b.x)], 1u);
            asm volatile("s_waitcnt vmcnt(0)" ::: "memory");
        } else {
            XB_SPIN(xb_ld(&bar[XB_XGEN(b.x)]) == gen, bar);
            __builtin_amdgcn_fence(__ATOMIC_ACQUIRE, "agent");
            asm volatile("s_waitcnt vmcnt(0)" ::: "memory");
        }
    }
    __syncthreads();
}
constexpr int NWAVES = 8, NTHR = 512;
constexpr int BATCH = 8, SEQ = 2048, D = 1024, M = BATCH * SEQ, DFF = 2816, NFF = 2 * DFF, NMOD = 9 * D;
constexpr int INC = 2832, PROJW = 3072;
constexpr int P_GQ = 0, P_GK = 192, P_GV = 384, P_GG = 768, P_SQ = 1152, P_SK = 1536, P_SV = 1920, P_CUA = 2304, P_CUG = 2560, P_GR = 2816;
constexpr float EPS = 1e-6f;
constexpr int NPL = 12, NPH = 1 + 2 * NPL;

constexpr size_t MiB = 1u << 20;
constexpr size_t WS_CTL = 0, CTL_ZERO_BYTES = 1 * MiB;
constexpr size_t WS_MOD = 1 * MiB;
constexpr size_t WS_WT = 2 * MiB, WT_LAYER = 41 * MiB;
constexpr size_t WT_1A = 0, WT_1B = 11 * MiB, WT_IN = 11 * MiB + 5632 * 1024, WT_OUT = WT_IN + 6 * MiB, WT_2A = WT_OUT + 2 * MiB, WT_2B = WT_2A + 11 * MiB;
static_assert(WT_2B + 5632 * 1024 == WT_LAYER, "weight map");
constexpr size_t WS_XN = 84 * MiB;
constexpr size_t WS_U = 116 * MiB;
constexpr size_t WS_LOGA = 212 * MiB;
constexpr size_t WS_GLARAW = 224 * MiB;
constexpr size_t WS_VT = 248 * MiB;
constexpr size_t WS_SLOC = 260 * MiB;
constexpr size_t WS_ADEC = 278 * MiB;
constexpr size_t WS_END = 279 * MiB;
static_assert(WS_WT + 2 * WT_LAYER == WS_XN && WS_XN + (size_t)M * D * 2 == WS_U && WS_U + (size_t)M * PROJW * 2 == WS_LOGA && WS_LOGA + (size_t)M * 192 * 4 == WS_GLARAW && WS_GLARAW + (size_t)M * 384 * 4 == WS_VT && WS_VT + (size_t)48 * 64 * SEQ * 2 == WS_SLOC && WS_SLOC + (size_t)1024 * 48 * 96 * 4 == WS_ADEC && WS_ADEC + 1024 * 48 * 4 <= WS_END, "d_ws map");
constexpr int CW_BAR = 4096;

constexpr int RING_OFF = 0, RING_BYTES = 131072;
constexpr int LDSCTL_OFF = RING_BYTES, MISC_OFF = LDSCTL_OFF + 320;
constexpr int LDS_BYTES = 147456;
struct Args { const float* in[23]; float* out; unsigned char* ws; int ph_lo, ph_hi; };
struct Frame {
    LAS unsigned char* lds;
    volatile LAS unsigned* MISC;
    gu32* ctl;
    int tid, lane, wave, G;
    float* out; unsigned char* ws;
    float* MOD; bf16* XN; bf16* U; bf16* PROJ; float* LOGA; float* GLARAW; bf16* VT; float* SLOC; float* ADEC;
};
__device__ __forceinline__ float bf2f(unsigned short v) { return __builtin_bit_cast(float, (unsigned)v << 16); }
__device__ __forceinline__ float bflo(unsigned w) { return __builtin_bit_cast(float, w << 16); }
__device__ __forceinline__ float bfhi(unsigned w) { return __builtin_bit_cast(float, w & 0xffff0000u); }
__device__ __forceinline__ float wave_sum(float v) {
#pragma unroll
    for (int o = 1; o < 64; o <<= 1) v += __shfl_xor(v, o);
    return v;
}
__device__ __forceinline__ float softplus_acc(float z) { return fmaxf(z, 0.f) + log1pf(expf(-fabsf(z))); }
__device__ __forceinline__ float silu_acc(float a) { return a / (1.0f + expf(-a)); }
__device__ __forceinline__ bf16* wt_ptr(Frame& F, int l, size_t off) { return (bf16*)(F.ws + WS_WT + (size_t)l * WT_LAYER + off); }

__device__ __forceinline__ void tr_item(const float* W, int ldw, int src_col0, int nvalid, bf16* WT, int ldk, int dest_row0, int k0, LAS float* scr, int lane) {
    const int nn = lane & 31;
    if (nvalid == 32) {
#pragma unroll 8
        for (int i = 0; i < 32; ++i) { const int kk = 2 * i + (lane >> 5); scr[kk * 33 + nn] = W[(size_t)(k0 + kk) * ldw + src_col0 + nn]; }
    } else {
        const bool ok = nn < nvalid;
#pragma unroll 8
        for (int i = 0; i < 32; ++i) { const int kk = 2 * i + (lane >> 5); float v = 0.f; if (ok) v = W[(size_t)(k0 + kk) * ldw + src_col0 + nn]; scr[kk * 33 + nn] = v; }
    }
    LDS_WAIT(); asm volatile("" ::: "memory");
    const int c = lane & 7;
#pragma unroll
    for (int j = 0; j < 4; ++j) { const int n = (lane >> 3) + 8 * j; const LAS float* s = scr + (8 * c) * 33 + n;
        v4u o; o.x = pk2(s[0 * 33], s[1 * 33]); o.y = pk2(s[2 * 33], s[3 * 33]); o.z = pk2(s[4 * 33], s[5 * 33]); o.w = pk2(s[6 * 33], s[7 * 33]);
        *(v4u*)(WT + (size_t)(dest_row0 + n) * ldk + k0 + 8 * c) = o; }
    LDS_WAIT(); asm volatile("" ::: "memory");
}
constexpr int I_A = 16 * 176, I_B = 44 * 32, I_IN = 16 * 96, I_OUT = 16 * 32, I_LAYER = 2 * I_A + 2 * I_B + I_IN + I_OUT;
__device__ __forceinline__ void tr_swiglu(Frame& F, const float* W, bf16* WT, int r, LAS float* scr) {
    const int kb = r / 176, g = r % 176, pn = g >> 3, r8 = g & 7;
    const int src = (r8 < 4) ? 128 * pn + 32 * r8 : DFF + 128 * pn + 32 * (r8 - 4);
    tr_item(W, NFF, src, 32, WT, D, 32 * g, 64 * kb, scr, F.lane);
}
__device__ __forceinline__ void tr_plain(Frame& F, const float* W, int K, int N, bf16* WT, int r, LAS float* scr) {
    const int ng = N / 32, kb = r / ng, g = r % ng;
    tr_item(W, N, 32 * g, 32, WT, K, 32 * g, 64 * kb, scr, F.lane);
}
__device__ __forceinline__ void tr_inproj(Frame& F, const float* W, bf16* WT, int r, LAS float* scr) {
    const int kb = r / 96, g = r % 96, d0 = 32 * g;
    int src = d0, nv = 32;
    if (d0 >= 1152 && d0 < 2816) src = d0 + 16; else if (d0 == 2816) { src = 1152; nv = 16; } else if (d0 > 2816) { src = 0; nv = 0; }
    tr_item(W, INC, src, nv, WT, D, d0, 64 * kb, scr, F.lane);
}
__device__ __forceinline__ void p0_prologue(Frame& F, const Args& A) {
    LAS float* cact = (LAS float*)(F.lds);
    LAS float* part = (LAS float*)(F.lds + 32768);
    const float* c = A.in[1];
    for (int i = F.tid; i < BATCH * D; i += NTHR) cact[i] = silu_acc(c[i]);
    __syncthreads();
    for (int item = blockIdx.x; item < 2 * 144; item += F.G) {
        const int l = item / 144, n0 = (item % 144) * 64;
        const float* W = A.in[2] + (size_t)l * D * NMOD;
        const int kk = F.lane >> 4, c4 = (F.lane & 15) * 4;
        float acc[8][4];
#pragma unroll
        for (int b = 0; b < 8; ++b)
#pragma unroll
            for (int j = 0; j < 4; ++j) acc[b][j] = 0.f;
#pragma unroll 8
        for (int i = 0; i < 32; ++i) {
            const int k = F.wave * 128 + i * 4 + kk;
            const f32x4 w = *(const f32x4*)(W + (size_t)k * NMOD + n0 + c4);
#pragma unroll
            for (int b = 0; b < 8; ++b) { const float cv = cact[b * D + k];
#pragma unroll
                for (int j = 0; j < 4; ++j) acc[b][j] += cv * w[j]; }
        }
#pragma unroll
        for (int b = 0; b < 8; ++b)
#pragma unroll
            for (int j = 0; j < 4; ++j) { float v = acc[b][j]; v += __shfl_xor(v, 16); v += __shfl_xor(v, 32); acc[b][j] = v; }
        if (kk == 0) {
#pragma unroll
            for (int b = 0; b < 8; ++b)
#pragma unroll
                for (int j = 0; j < 4; ++j) part[(F.wave * 8 + b) * 64 + c4 + j] = acc[b][j];
        }
        __syncthreads();
        { const int b = F.tid >> 6, col = F.tid & 63; float s = A.in[3][l * NMOD + n0 + col];
#pragma unroll
            for (int w = 0; w < 8; ++w) s += part[(w * 8 + b) * 64 + col];
            F.MOD[(size_t)(l * 8 + b) * NMOD + n0 + col] = s; }
        __syncthreads();
    }
    LAS float* scr = (LAS float*)(F.lds + F.wave * 16384);
    const int gw = blockIdx.x * NWAVES + F.wave, NGW = F.G * NWAVES;
    for (int it = gw; it < 2 * I_LAYER; it += NGW) {
        const int l = it / I_LAYER; int r = it % I_LAYER;
        if (r < I_A) { tr_swiglu(F, A.in[5] + (size_t)l * D * NFF, wt_ptr(F, l, WT_1A), r, scr); continue; } r -= I_A;
        if (r < I_B) { tr_plain(F, A.in[6] + (size_t)l * DFF * D, DFF, D, wt_ptr(F, l, WT_1B), r, scr); continue; } r -= I_B;
        if (r < I_IN) { tr_inproj(F, A.in[8] + (size_t)l * D * INC, wt_ptr(F, l, WT_IN), r, scr); continue; } r -= I_IN;
        if (r < I_OUT) { tr_plain(F, A.in[9] + (size_t)l * D * D, D, D, wt_ptr(F, l, WT_OUT), r, scr); continue; } r -= I_OUT;
        if (r < I_A) { tr_swiglu(F, A.in[21] + (size_t)l * D * NFF, wt_ptr(F, l, WT_2A), r, scr); continue; } r -= I_A;
        tr_plain(F, A.in[22] + (size_t)l * DFF * D, DFF, D, wt_ptr(F, l, WT_2B), r, scr);
    }
}

__device__ __forceinline__ void norm_phase(Frame& F, const float* xsrc, const float* gain, const float* modl, int jsh) {
    const int gw = blockIdx.x * NWAVES + F.wave, NGW = F.G * NWAVES;
    for (int m = gw; m < M; m += NGW) {
        const float* sh = modl + (size_t)(m >> 11) * NMOD + jsh * D; const float* sc = sh + D;
        const f32x4* xr = (const f32x4*)(xsrc + (size_t)m * D) + F.lane;
        f32x4 v[4]; float s = 0.f;
#pragma unroll
        for (int j = 0; j < 4; ++j) { v[j] = xr[64 * j]; s += (v[j].x * v[j].x + v[j].y * v[j].y) + (v[j].z * v[j].z + v[j].w * v[j].w); }
        const float rstd = 1.0f / sqrtf(wave_sum(s) * (1.f / D) + EPS);
        unsigned long long* o8 = (unsigned long long*)(F.XN + (size_t)m * D) + F.lane;
#pragma unroll
        for (int j = 0; j < 4; ++j) {
            const f32x4 g4 = ((const f32x4*)gain)[F.lane + 64 * j], s4 = ((const f32x4*)sc)[F.lane + 64 * j], h4 = ((const f32x4*)sh)[F.lane + 64 * j];
            const f32x4 y = v[j] * rstd * g4 * (s4 + 1.0f) + h4;
            o8[64 * j] = (unsigned long long)pk2(y.x, y.y) | ((unsigned long long)pk2(y.z, y.w) << 32);
        }
    }
}
constexpr float LOG2E = 1.4426950408889634f;
constexpr float QSCALE = 0.125f * LOG2E;
constexpr float GLA_SCALE = 0.14433756729740643f;
constexpr float SB_EXIT = -160.0f;
typedef float f32x16 __attribute__((ext_vector_type(16)));
__device__ __forceinline__ float ex2(float x) { return __builtin_amdgcn_exp2f(x); }
__device__ __forceinline__ float lg2(float x) { return __builtin_amdgcn_logf(x); }
__device__ __forceinline__ float silu_fast(float a) { return a * __builtin_amdgcn_rcpf(1.0f + ex2(-LOG2E * a)); }
typedef float f32x2_t __attribute__((ext_vector_type(2))); typedef __bf16 bf16x2_t __attribute__((ext_vector_type(2)));
__device__ __forceinline__ unsigned cvtpk(float lo, float hi) { f32x2_t v = {lo, hi}; bf16x2_t b = __builtin_convertvector(v, bf16x2_t); return __builtin_bit_cast(unsigned, b); }

__device__ __forceinline__ void mix_prepass(Frame& F, const Args& A, int l) {
    const int gw = blockIdx.x * NWAVES + F.wave, NGW = F.G * NWAVES, lane = F.lane;
    const float* gq = A.in[13] + l * 64; const float* gk = A.in[14] + l * 64;
    const float* Wup = A.in[10] + l * 16 * 192; const float* bg = A.in[11] + l * 192;
    for (int m = gw; m < M; m += NGW) {
        bf16* row = F.PROJ + (size_t)m * PROJW;
#pragma unroll
        for (int p = 0; p < 3; ++p) {
            const int e0 = 256 * p + 4 * lane;
            unsigned long long* ptr = (unsigned long long*)(row + P_SQ + e0);
            const unsigned long long w = *ptr;
            const float x0 = bflo((unsigned)w), x1 = bfhi((unsigned)w), x2 = bflo((unsigned)(w >> 32)), x3 = bfhi((unsigned)(w >> 32));
            float ss = (x0 * x0 + x1 * x1) + (x2 * x2 + x3 * x3);
            ss += __shfl_xor(ss, 1); ss += __shfl_xor(ss, 2); ss += __shfl_xor(ss, 4); ss += __shfl_xor(ss, 8);
            const bool isq = e0 < 384;
            const float r = (isq ? QSCALE : 1.0f) / sqrtf(ss * (1.f / 64.f) + EPS);
            const f32x4 g4 = *(const f32x4*)((isq ? gq : gk) + (e0 & 63));
            *ptr = (unsigned long long)pk2(x0 * r * g4.x, x1 * r * g4.y) | ((unsigned long long)pk2(x2 * r * g4.z, x3 * r * g4.w) << 32);
        }
        const v4u g0 = *(const v4u*)(row + P_GR), g1 = *(const v4u*)(row + P_GR + 8);
        float gr[16];
#pragma unroll
        for (int e = 0; e < 4; ++e) { gr[2 * e] = bflo(g0[e]); gr[2 * e + 1] = bfhi(g0[e]); gr[8 + 2 * e] = bflo(g1[e]); gr[8 + 2 * e + 1] = bfhi(g1[e]); }
#pragma unroll
        for (int i = 0; i < 3; ++i) { const int j = lane + 64 * i; float x = bg[j];
#pragma unroll
            for (int r = 0; r < 16; ++r) x += gr[r] * Wup[r * 192 + j];
            const float sp2 = fmaxf(-x, 0.f) * LOG2E + lg2(1.0f + ex2(-fabsf(x) * LOG2E));
            F.LOGA[(size_t)m * 192 + j] = -sp2 * (1.0f / 16.0f); }
    }
    LAS unsigned short* tile = (LAS unsigned short*)(F.lds + F.wave * 16384);
    for (int it = gw; it < 256 * 12; it += NGW) {
        const int tbg = it / 12, cg = it % 12, b = tbg >> 5, t0 = (tbg & 31) * 64, h = cg >> 1, d0 = (cg & 1) * 32;
        const v4u* src = (const v4u*)(F.PROJ + (size_t)(b * SEQ + t0 + lane) * PROJW + P_SV + 32 * cg);
#pragma unroll
        for (int i = 0; i < 4; ++i) { const v4u w = src[i];
#pragma unroll
            for (int e = 0; e < 4; ++e) { tile[(8 * i + 2 * e) * 72 + lane] = (unsigned short)(w[e] & 0xffffu); tile[(8 * i + 2 * e + 1) * 72 + lane] = (unsigned short)(w[e] >> 16); } }
        LDS_WAIT(); asm volatile("" ::: "memory");
#pragma unroll
        for (int i = 0; i < 4; ++i) { const int p = 64 * i + lane, col = p >> 3, ch = p & 7;
            const v4u v = *(const LAS v4u*)(tile + col * 72 + ch * 8);
            *(v4u*)(F.VT + (size_t)((b * 6 + h) * 64 + d0 + col) * SEQ + t0 + ch * 8) = v; }
        LDS_WAIT(); asm volatile("" ::: "memory");
    }
}

__device__ __forceinline__ int crow(int r, int hi) { return (r & 3) + 8 * (r >> 2) + 4 * hi; }
__device__ __forceinline__ void sb_strip(Frame& F, const float* gn, int b, int h, int s) {
    const int lane = F.lane, r32 = lane & 31, hi = lane >> 5, q0 = 32 * s, t = q0 + r32;
    const bf16* Qrow = F.PROJ + (size_t)(b * SEQ + t) * PROJW + P_SQ + h * 64 + 8 * hi;
    bf16x8 qf[4], kf[4];
#pragma unroll
    for (int st = 0; st < 4; ++st) qf[st] = *(const bf16x8*)(Qrow + 16 * st);
    const bf16* Kb = F.PROJ + (size_t)(b * SEQ + r32) * PROJW + P_SK + h * 64 + 8 * hi;
    const bf16* Vb = F.VT + (size_t)((b * 6 + h) * 64 + r32) * SEQ + 4 * hi;
#pragma unroll
    for (int st = 0; st < 4; ++st) kf[st] = *(const bf16x8*)(Kb + (size_t)q0 * PROJW + 16 * st);
    f32x16 o0, o1;
#pragma unroll
    for (int r = 0; r < 16; ++r) { o0[r] = 0.f; o1[r] = 0.f; }
    float C = 0.f;
    for (int kt = s; kt >= 0; --kt) {
        const int k0 = 32 * kt;
        unsigned long long vlo[2][2], vhi[2][2];
#pragma unroll
        for (int db = 0; db < 2; ++db)
#pragma unroll
            for (int s2 = 0; s2 < 2; ++s2) { const bf16* vp = Vb + (size_t)(32 * db) * SEQ + k0 + 16 * s2;
                vlo[db][s2] = *(const unsigned long long*)vp; vhi[db][s2] = *(const unsigned long long*)(vp + 8); }
        f32x16 acc;
#pragma unroll
        for (int r = 0; r < 16; ++r) acc[r] = 0.f;
#pragma unroll
        for (int st = 0; st < 4; ++st) acc = __builtin_amdgcn_mfma_f32_32x32x16_bf16(kf[st], qf[st], acc, 0, 0, 0);
        if (kt > 0) {
#pragma unroll
            for (int st = 0; st < 4; ++st) kf[st] = *(const bf16x8*)(Kb + (size_t)(k0 - 32) * PROJW + 16 * st);
        }
        const bool diag = (kt == s);
        float lk[16], lb[16];
#pragma unroll
        for (int r = 0; r < 16; ++r) {
            const float z = acc[r];
            const float sp = fmaxf(z, 0.f) + lg2(1.0f + ex2(-fabsf(z)));
            lk[r] = -sp; lb[r] = z - sp;
            if (diag && (k0 + crow(r, hi) >= t)) { lk[r] = 0.f; lb[r] = -INFINITY; }
        }
        float gs[4], pgs[4], tail[4];
#pragma unroll
        for (int g = 0; g < 4; ++g) { gs[g] = (lk[4 * g] + lk[4 * g + 1]) + (lk[4 * g + 2] + lk[4 * g + 3]); pgs[g] = __shfl_xor(gs[g], 32); }
        tail[3] = 0.f; tail[2] = gs[3] + pgs[3]; tail[1] = tail[2] + (gs[2] + pgs[2]); tail[0] = tail[1] + (gs[1] + pgs[1]);
        const float T = tail[0] + (gs[0] + pgs[0]);
        float w[16];
#pragma unroll
        for (int g = 0; g < 4; ++g) {
            float x = tail[g] + (hi == 0 ? pgs[g] : 0.f) + C;
            w[4 * g + 3] = ex2(lb[4 * g + 3] + x); x += lk[4 * g + 3];
            w[4 * g + 2] = ex2(lb[4 * g + 2] + x); x += lk[4 * g + 2];
            w[4 * g + 1] = ex2(lb[4 * g + 1] + x); x += lk[4 * g + 1];
            w[4 * g + 0] = ex2(lb[4 * g + 0] + x);
        }
        C += T;
        v4u pw0, pw1;
#pragma unroll
        for (int e = 0; e < 4; ++e) { pw0[e] = cvtpk(w[2 * e], w[2 * e + 1]); pw1[e] = cvtpk(w[8 + 2 * e], w[8 + 2 * e + 1]); }
        const bf16x8 pb0 = __builtin_bit_cast(bf16x8, pw0), pb1 = __builtin_bit_cast(bf16x8, pw1);
#pragma unroll
        for (int db = 0; db < 2; ++db) {
            v4u a0, a1;
            a0[0] = (unsigned)vlo[db][0]; a0[1] = (unsigned)(vlo[db][0] >> 32); a0[2] = (unsigned)vhi[db][0]; a0[3] = (unsigned)(vhi[db][0] >> 32);
            a1[0] = (unsigned)vlo[db][1]; a1[1] = (unsigned)(vlo[db][1] >> 32); a1[2] = (unsigned)vhi[db][1]; a1[3] = (unsigned)(vhi[db][1] >> 32);
            if (db == 0) { o0 = __builtin_amdgcn_mfma_f32_32x32x16_bf16(__builtin_bit_cast(bf16x8, a0), pb0, o0, 0, 0, 0); o0 = __builtin_amdgcn_mfma_f32_32x32x16_bf16(__builtin_bit_cast(bf16x8, a1), pb1, o0, 0, 0, 0); }
            else         { o1 = __builtin_amdgcn_mfma_f32_32x32x16_bf16(__builtin_bit_cast(bf16x8, a0), pb0, o1, 0, 0, 0); o1 = __builtin_amdgcn_mfma_f32_32x32x16_bf16(__builtin_bit_cast(bf16x8, a1), pb1, o1, 0, 0, 0); }
        }
        if (!diag && __all(C < SB_EXIT)) break;
    }
    float ss = 0.f;
#pragma unroll
    for (int r = 0; r < 16; ++r) ss += o0[r] * o0[r] + o1[r] * o1[r];
    ss += __shfl_xor(ss, 32);
    const float rs = 1.0f / sqrtf(ss * (1.f / 64.f) + EPS);
    bf16* orow = F.XN + (size_t)(b * SEQ + t) * D + 384 + h * 64 + 4 * hi;
#pragma unroll
    for (int db = 0; db < 2; ++db)
#pragma unroll
        for (int g = 0; g < 4; ++g) { const int d = 32 * db + 8 * g;
            const f32x4 g4 = *(const f32x4*)(gn + d + 4 * hi);
            float v0, v1, v2, v3;
            if (db == 0) { v0 = o0[4 * g]; v1 = o0[4 * g + 1]; v2 = o0[4 * g + 2]; v3 = o0[4 * g + 3]; } else { v0 = o1[4 * g]; v1 = o1[4 * g + 1]; v2 = o1[4 * g + 2]; v3 = o1[4 * g + 3]; }
            *(unsigned long long*)(orow + d) = (unsigned long long)cvtpk(v0 * rs * g4.x, v1 * rs * g4.y) | ((unsigned long long)cvtpk(v2 * rs * g4.z, v3 * rs * g4.w) << 32); }
}

__device__ __forceinline__ f32x4 conv_u(const bf16* row, int ch) {
    const unsigned long long aw = *(const unsigned long long*)(row + P_CUA + ch), gw2 = *(const unsigned long long*)(row + P_CUG + ch);
    const float a0 = bflo((unsigned)aw), a1 = bfhi((unsigned)aw), a2 = bflo((unsigned)(aw >> 32)), a3 = bfhi((unsigned)(aw >> 32));
    const float g0 = bflo((unsigned)gw2), g1 = bfhi((unsigned)gw2), g2 = bflo((unsigned)(gw2 >> 32)), g3 = bfhi((unsigned)(gw2 >> 32));
    f32x4 u;
    u.x = a0 * __builtin_amdgcn_rcpf(1.0f + ex2(-LOG2E * g0)); u.y = a1 * __builtin_amdgcn_rcpf(1.0f + ex2(-LOG2E * g1));
    u.z = a2 * __builtin_amdgcn_rcpf(1.0f + ex2(-LOG2E * g2)); u.w = a3 * __builtin_amdgcn_rcpf(1.0f + ex2(-LOG2E * g3));
    return u;
}
__device__ __forceinline__ void conv_run(Frame& F, const Args& A, int l, int run) {
    const int lane = F.lane, ch = 4 * lane, m0 = 8 * run, t0 = m0 & (SEQ - 1);
    const float* cwt = A.in[16] + l * 31 * 256 + ch;
    f32x4 acc[8];
    { const f32x4 cb = *(const f32x4*)(A.in[17] + l * 256 + ch);
#pragma unroll
      for (int k = 0; k < 8; ++k) acc[k] = cb; }
#pragma unroll
    for (int j = 0; j < 7; ++j) {
        if (t0 - 30 + j >= 0) { const f32x4 u = conv_u(F.PROJ + (size_t)(m0 - 30 + j) * PROJW, ch);
#pragma unroll
            for (int k = 0; k <= j; ++k) acc[k] += *(const f32x4*)(cwt + (j - k) * 256) * u; }
    }
#pragma unroll 2
    for (int j = 7; j <= 30; ++j) {
        if (t0 - 30 + j >= 0) { const f32x4 u = conv_u(F.PROJ + (size_t)(m0 - 30 + j) * PROJW, ch); const float* wj = cwt + j * 256;
#pragma unroll
            for (int k = 0; k < 8; ++k) acc[k] += *(const f32x4*)(wj - k * 256) * u; }
    }
#pragma unroll
    for (int j = 31; j < 38; ++j) {
        const f32x4 u = conv_u(F.PROJ + (size_t)(m0 - 30 + j) * PROJW, ch);
#pragma unroll
        for (int k = j - 30; k < 8; ++k) acc[k] += *(const f32x4*)(cwt + (j - k) * 256) * u;
    }
    const f32x4 lg = *(const f32x4*)(A.in[18] + l * 256 + ch), lbv = *(const f32x4*)(A.in[19] + l * 256 + ch);
#pragma unroll
    for (int k = 0; k < 8; ++k) {
        const float mean = wave_sum((acc[k].x + acc[k].y) + (acc[k].z + acc[k].w)) * (1.f / 256.f);
        const f32x4 d = acc[k] - mean;
        const float rstd = 1.0f / sqrtf(wave_sum((d.x * d.x + d.y * d.y) + (d.z * d.z + d.w * d.w)) * (1.f / 256.f) + EPS);
        const f32x4 y = d * rstd * lg + lbv;
        *(unsigned long long*)(F.XN + (size_t)(m0 + k) * D + 768 + ch) = (unsigned long long)cvtpk(silu_fast(y.x), silu_fast(y.y)) | ((unsigned long long)cvtpk(silu_fast(y.z), silu_fast(y.w)) << 32);
    }
}

__device__ __forceinline__ void gla_pass1(Frame& F, int u) {
    const int lane = F.lane, b = u >> 7, h = (u >> 5) & 3, c = u & 31, m0 = b * SEQ + c * 64, dv0 = lane, dv1 = 64 + (lane & 31);
    LAS float* sa = (LAS float*)(F.lds + F.wave * 16384); LAS float* sk = sa + 768; LAS float* sq = sk + 768; LAS float* sv = sq + 768;
    float S0[48], S1[48];
#pragma unroll
    for (int k = 0; k < 48; ++k) { S0[k] = 0.f; S1[k] = 0.f; }
    float P = 1.0f;
    for (int sb = 0; sb < 4; ++sb) {
        const int mb = m0 + sb * 16;
#pragma unroll 2
        for (int i = 0; i < 12; ++i) { const int idx = lane + 64 * i, tt = idx / 48, k = idx - tt * 48; const size_t m = (size_t)(mb + tt);
            sa[idx] = ex2(F.LOGA[m * 192 + h * 48 + k]); sk[idx] = bf2f(F.PROJ[m * PROJW + P_GK + h * 48 + k]); sq[idx] = bf2f(F.PROJ[m * PROJW + P_GQ + h * 48 + k]); }
#pragma unroll 2
        for (int i = 0; i < 24; ++i) { const int idx = lane + 64 * i, tt = idx / 96, dv = idx - tt * 96; sv[idx] = bf2f(F.PROJ[(size_t)(mb + tt) * PROJW + P_GV + h * 96 + dv]); }
        LDS_WAIT(); asm volatile("" ::: "memory");
        if (lane < 48) {
#pragma unroll
            for (int tt = 0; tt < 16; ++tt) { P *= sa[tt * 48 + lane]; F.LOGA[(size_t)(mb + tt) * 192 + h * 48 + lane] = sq[tt * 48 + lane] * P * GLA_SCALE; }
        }
#pragma unroll
        for (int tt = 0; tt < 16; ++tt) {
            float oa = 0.f, ob = 0.f; const float v0 = sv[tt * 96 + dv0], v1 = sv[tt * 96 + dv1];
#pragma unroll
            for (int k4 = 0; k4 < 12; ++k4) {
                const f32x4 a4 = *(const LAS f32x4*)(sa + tt * 48 + 4 * k4), k4v = *(const LAS f32x4*)(sk + tt * 48 + 4 * k4), q4v = *(const LAS f32x4*)(sq + tt * 48 + 4 * k4);
#pragma unroll
                for (int e = 0; e < 4; ++e) { const int k = 4 * k4 + e;
                    S0[k] = a4[e] * S0[k] + k4v[e] * v0; oa += q4v[e] * S0[k];
                    S1[k] = a4[e] * S1[k] + k4v[e] * v1; ob += q4v[e] * S1[k]; }
            }
            float* orow = F.GLARAW + (size_t)(mb + tt) * 384 + h * 96;
            orow[dv0] = oa * GLA_SCALE; if (lane < 32) orow[dv1] = ob * GLA_SCALE;
        }
        LDS_WAIT(); asm volatile("" ::: "memory");
    }
    float* sl = F.SLOC + (size_t)u * 48 * 96;
#pragma unroll
    for (int k = 0; k < 48; ++k) { sl[k * 96 + dv0] = S0[k]; if (lane < 32) sl[k * 96 + dv1] = S1[k]; }
    if (lane < 48) F.ADEC[u * 48 + lane] = P;
}

__device__ __forceinline__ void mix_phase_b(Frame& F, const Args& A, int l) {
    if (F.wave < 4) { gla_pass1(F, blockIdx.x * 4 + F.wave); return; }
    const int sw = blockIdx.x * 4 + (F.wave - 4);
    const float* gn = A.in[15] + l * 64;
    for (int i = 0; i < 3; ++i) { const int rho = (i == 0) ? sw : (i == 1) ? 2047 - sw : 2048 + sw; const int s = 63 - rho / 48, bh = rho % 48; sb_strip(F, gn, bh / 6, bh % 6, s); }
    conv_run(F, A, l, sw); conv_run(F, A, l, sw + 1024);
}

__device__ __forceinline__ void mix_phase_c(Frame& F, const Args& A, int l) {
    if (F.wave >= 4) return;
    const int u = blockIdx.x * 4 + F.wave, lane = F.lane, b = u >> 7, h = (u >> 5) & 3, c = u & 31, m0 = b * SEQ + c * 64, dv0 = lane, dv1 = 64 + (lane & 31);
    float S0[48], S1[48];
#pragma unroll
    for (int k = 0; k < 48; ++k) { S0[k] = 0.f; S1[k] = 0.f; }
    for (int cp = 0; cp < c; ++cp) {
        const int up = u - c + cp; const float* ad = F.ADEC + up * 48; const float* sl = F.SLOC + (size_t)up * 48 * 96;
#pragma unroll
        for (int k4 = 0; k4 < 12; ++k4) { const f32x4 a4 = *(const f32x4*)(ad + 4 * k4);
#pragma unroll
            for (int e = 0; e < 4; ++e) { const int k = 4 * k4 + e; S0[k] = a4[e] * S0[k] + sl[k * 96 + dv0]; S1[k] = a4[e] * S1[k] + sl[k * 96 + dv1]; } }
    }
    const float gn0 = A.in[12][l * 96 + dv0], gn1 = A.in[12][l * 96 + dv1];
    for (int tt = 0; tt < 64; ++tt) {
        const size_t m = (size_t)(m0 + tt);
        const float* orow = F.GLARAW + m * 384 + h * 96; const float* qd = F.LOGA + m * 192 + h * 48;
        float oa = orow[dv0], ob = orow[dv1];
#pragma unroll
        for (int k4 = 0; k4 < 12; ++k4) { const f32x4 q4 = *(const f32x4*)(qd + 4 * k4);
#pragma unroll
            for (int e = 0; e < 4; ++e) { oa += q4[e] * S0[4 * k4 + e]; ob += q4[e] * S1[4 * k4 + e]; } }
        const float ss = wave_sum(oa * oa + (lane < 32 ? ob * ob : 0.f));
        const float r = 1.0f / sqrtf(ss * (1.f / 96.f) + EPS);
        const bf16* gg = F.PROJ + m * PROJW + P_GG + h * 96;
        bf16* mo = F.XN + m * D + h * 96;
        mo[dv0] = (bf16)f2bf(oa * r * gn0 * silu_fast(bf2f(gg[dv0])));
        if (lane < 32) mo[dv1] = (bf16)f2bf(ob * r * gn1 * silu_fast(bf2f(gg[dv1])));
    }
}
#ifndef MK_SINGLE
#define MK_SINGLE 1
#endif
#define IN(k) (lo <= (k) && (k) < hi)
#define SEAM(k) do { if (MK_SINGLE && IN((k) + 1)) xcd_barrier(bar); } while (0)
template <int l> __device__ __forceinline__ void layer_phases(Frame& F, const Args& A, const XcdBarrier& bar, const int lo, const int hi) {
        const int pb = 1 + l * NPL;
        const float* modl = F.MOD + (size_t)l * 8 * NMOD;
        const float* xfirst = (l == 0) ? A.in[0] : F.out;
        if (IN(pb + 0)) { norm_phase(F, xfirst, A.in[4] + l * D, modl, 0); SEAM(pb + 0); }
        if (IN(pb + 1)) { pg8::Gemm g{F.XN, wt_ptr(F, l, WT_1A), M, NFF, D}; pg8::StaticOrder S; S.init(M, NFF, F.G, (int)blockIdx.x);
            pg8::EpiSwiGLU E{F.U, DFF}; pg8::gemm_phase<pg8::EpiSwiGLU, pg8::StaticOrder, true, true>(F.lds + RING_OFF, g, S, E); SEAM(pb + 1); }
        if (IN(pb + 2)) { pg8::Gemm g{F.U, wt_ptr(F, l, WT_1B), M, D, DFF}; pg8::StaticOrder S; S.init(M, D, F.G, (int)blockIdx.x);
            pg8::EpiResid E{xfirst, F.out, modl + 2 * D, 0.5f}; pg8::gemm_phase<pg8::EpiResid, pg8::StaticOrder, true, true>(F.lds + RING_OFF, g, S, E); SEAM(pb + 2); }
        if (IN(pb + 3)) { norm_phase(F, F.out, A.in[7] + l * D, modl, 3); SEAM(pb + 3); }
        if (IN(pb + 4)) { pg8::Gemm g{F.XN, wt_ptr(F, l, WT_IN), M, PROJW, D}; pg8::StaticOrder S; S.init(M, PROJW, F.G, (int)blockIdx.x);
            pg8::EpiBf16<0> E{F.PROJ, PROJW, nullptr, 0, 0, 1.f}; pg8::gemm_phase<pg8::EpiBf16<0>, pg8::StaticOrder, true, true>(F.lds + RING_OFF, g, S, E); SEAM(pb + 4); }
        if (IN(pb + 5)) { mix_prepass(F, A, l); SEAM(pb + 5); }
        if (IN(pb + 6)) { mix_phase_b(F, A, l); SEAM(pb + 6); }
        if (IN(pb + 7)) { mix_phase_c(F, A, l); SEAM(pb + 7); }
        if (IN(pb + 8)) { pg8::Gemm g{F.XN, wt_ptr(F, l, WT_OUT), M, D, D}; pg8::StaticOrder S; S.init(M, D, F.G, (int)blockIdx.x);
            pg8::EpiResid E{F.out, F.out, modl + 5 * D, 1.0f}; pg8::gemm_phase<pg8::EpiResid, pg8::StaticOrder, true, true>(F.lds + RING_OFF, g, S, E); SEAM(pb + 8); }
        if (IN(pb + 9)) { norm_phase(F, F.out, A.in[20] + l * D, modl, 6); SEAM(pb + 9); }
        if (IN(pb + 10)) { pg8::Gemm g{F.XN, wt_ptr(F, l, WT_2A), M, NFF, D}; pg8::StaticOrder S; S.init(M, NFF, F.G, (int)blockIdx.x);
            pg8::EpiSwiGLU E{F.U, DFF}; pg8::gemm_phase<pg8::EpiSwiGLU, pg8::StaticOrder, true, true>(F.lds + RING_OFF, g, S, E); SEAM(pb + 10); }
        if (IN(pb + 11)) { pg8::Gemm g{F.U, wt_ptr(F, l, WT_2B), M, D, DFF}; pg8::StaticOrder S; S.init(M, D, F.G, (int)blockIdx.x);
            pg8::EpiResid E{F.out, F.out, modl + 8 * D, 0.5f}; pg8::gemm_phase<pg8::EpiResid, pg8::StaticOrder, true, true>(F.lds + RING_OFF, g, S, E); SEAM(pb + 11); }
}
__global__ void __launch_bounds__(NTHR, 2) mk_fwd(Args A) {
    extern __shared__ __attribute__((aligned(16))) unsigned char lds[];
    Frame F;
    F.lds = (LAS unsigned char*)lds;
    F.MISC = (volatile LAS unsigned*)(F.lds + MISC_OFF);
    F.tid = threadIdx.x; F.lane = F.tid & 63; F.wave = __builtin_amdgcn_readfirstlane(F.tid >> 6);
    F.G = gridDim.x;
    F.out = A.out; F.ws = A.ws;
    F.ctl = (gu32*)(A.ws + WS_CTL);
    F.MOD = (float*)(A.ws + WS_MOD); F.XN = (bf16*)(A.ws + WS_XN); F.U = (bf16*)(A.ws + WS_U); F.PROJ = (bf16*)(A.ws + WS_U);
    F.LOGA = (float*)(A.ws + WS_LOGA); F.GLARAW = (float*)(A.ws + WS_GLARAW); F.VT = (bf16*)(A.ws + WS_VT); F.SLOC = (float*)(A.ws + WS_SLOC); F.ADEC = (float*)(A.ws + WS_ADEC);
    for (int u = F.tid; u < (LDS_BYTES - LDSCTL_OFF) / 4; u += NTHR) ((LAS unsigned*)(F.lds + LDSCTL_OFF))[u] = 0u;
    __syncthreads();
    XcdBarrier bar; bar.bar = (unsigned*)(F.ctl + CW_BAR); bar.x = 0; bar.st = nullptr;
    if (MK_SINGLE) bar = xcd_barrier_post((unsigned*)(F.ctl + CW_BAR), F.MISC + 8);
    const int lo = A.ph_lo, hi = A.ph_hi;

    if (IN(0)) { p0_prologue(F, A); SEAM(0); }
    layer_phases<0>(F, A, bar, lo, hi);
    layer_phases<1>(F, A, bar, lo, hi);
#undef IN
#undef SEAM
}

extern "C" void kernel_launch(void* const* d_in, const int* in_sizes, int n_in, void* d_out, int out_size, void* d_ws, size_t ws_size, hipStream_t stream) {
    static int grid = 0;
    if (grid == 0) {
        if (n_in != 23 || in_sizes[0] != M * D || out_size != M * D || ws_size < WS_END) { fprintf(stderr, "kernel_launch: unexpected shapes (n_in %d, in0 %d, out %d, ws %zu); nothing launched\n", n_in, n_in > 0 ? in_sizes[0] : -1, out_size, ws_size); grid = -1; return; }
        int dev = 0, cus = 0, per_cu = 0;
        if (hipGetDevice(&dev) != hipSuccess || hipDeviceGetAttribute(&cus, hipDeviceAttributeMultiprocessorCount, dev) != hipSuccess) { grid = -1; return; }
        if (hipFuncSetAttribute((const void*)mk_fwd, hipFuncAttributeMaxDynamicSharedMemorySize, LDS_BYTES) != hipSuccess) { fprintf(stderr, "kernel_launch: hipFuncSetAttribute failed\n"); grid = -1; return; }
        if (hipOccupancyMaxActiveBlocksPerMultiprocessor(&per_cu, (const void*)mk_fwd, NTHR, LDS_BYTES) != hipSuccess || per_cu < 1) { fprintf(stderr, "kernel_launch: occupancy query says %d blocks per CU\n", per_cu); (void)hipGetLastError(); grid = -1; return; }
        grid = cus;
        if (grid != 256) { fprintf(stderr, "kernel_launch: built for 256 CUs, device has %d\n", cus); grid = -1; return; }
    }
    if (grid < 0) return;
    if (hipMemsetAsync((char*)d_ws + WS_CTL, 0, CTL_ZERO_BYTES, stream) != hipSuccess) return;
    Args a{};
    for (int i = 0; i < 23; ++i) a.in[i] = (const float*)d_in[i];
    a.out = (float*)d_out; a.ws = (unsigned char*)d_ws;
#if MK_SINGLE
    a.ph_lo = 0; a.ph_hi = NPH;
    hipLaunchKernelGGL(mk_fwd, dim3(grid), dim3(NTHR), LDS_BYTES, stream, a);
#else
    for (int p = 0; p < NPH; ++p) { a.ph_lo = p; a.ph_hi = p + 1; hipLaunchKernelGGL(mk_fwd, dim3(grid), dim3(NTHR), LDS_BYTES, stream, a); }
#endif
}
```
